# Optimizing an MI355X kernel written in HIP

```python
import jax, jax.numpy as jnp
from jax import lax
import numpy as np

D_MODEL = 2048
BATCH = 2
SEQ = 4096
DEPTH = 1
DEC_BATCH = 8
DEC_SEQ = 4
PAST_LEN = 16384
PAGE_SIZE = 128

ATTN_WIDTH = D_MODEL // 2
HEAD_DIM = 64
N_HEADS = ATTN_WIDTH // HEAD_DIM
DILATED_PATTERNS = ((128, 1), (512, 4), (2048, 16))
MAX_WINDOW = max(w for w, _ in DILATED_PATTERNS)
POOL_WIDTH = D_MODEL - ATTN_WIDTH
POOL_WINDOWS = (2, 4, 8, 16)
N_POOL_GROUPS = len(POOL_WINDOWS)
POOL_GROUP_WIDTH = POOL_WIDTH // N_POOL_GROUPS
POOL_HIST = max(POOL_WINDOWS) - 1
MIX_WIDTH = ATTN_WIDTH + POOL_WIDTH
IN_WIDTH = 4 * ATTN_WIDTH + 2 * POOL_WIDTH
BLOCK = 128
EPS = 1e-6
ATTN_SCALE = HEAD_DIM ** -0.5

kernel_name = "hymba_dilated_window_pool_hybrid_step"


def rms_norm(x, g):
    xf = x.astype(jnp.float32)
    y = xf * lax.rsqrt(jnp.mean(xf * xf, axis=-1, keepdims=True) + EPS)
    return (y * g.astype(jnp.float32)).astype(x.dtype)


def project(x, g, w_in):
    b, s, _ = x.shape
    z = jnp.einsum('bsd,de->bse', rms_norm(x, g), w_in)
    cuts = [ATTN_WIDTH, 2 * ATTN_WIDTH, 3 * ATTN_WIDTH, 4 * ATTN_WIDTH, 4 * ATTN_WIDTH + POOL_WIDTH]
    q, k, v, ga, u, gp = jnp.split(z, cuts, axis=-1)
    hs = (b, s, N_HEADS, HEAD_DIM)
    return q.reshape(hs), k.reshape(hs), v.reshape(hs), ga, u, gp


def band_attention(q, k, v, window_steps):
    assert window_steps <= BLOCK
    n, m, h, dh = q.shape
    nb = m // BLOCK
    qb = q.reshape(n, nb, BLOCK, h, dh)
    kb = k.reshape(n, nb, BLOCK, h, dh)
    vb = v.reshape(n, nb, BLOCK, h, dh)
    pad = ((0, 0), (1, 0), (0, 0), (0, 0), (0, 0))
    kcat = jnp.concatenate([jnp.pad(kb, pad)[:, :-1], kb], axis=2)
    vcat = jnp.concatenate([jnp.pad(vb, pad)[:, :-1], vb], axis=2)
    s = jnp.einsum('nbqhd,nbkhd->nbhqk', qb, kcat,
                   preferred_element_type=jnp.float32) * ATTN_SCALE
    qi = jnp.arange(BLOCK)[:, None]
    ki = jnp.arange(2 * BLOCK)[None, :] - BLOCK
    dist = qi - ki
    band = (dist >= 0) & (dist <= window_steps)
    blk_start = jnp.arange(nb) * BLOCK
    valid = band[None] & ((blk_start[:, None, None] + ki[None]) >= 0)
    s = jnp.where(valid[None, :, None], s, -jnp.inf)
    lse = jax.nn.logsumexp(s, axis=-1)
    p = jnp.exp(s - lse[..., None])
    o = jnp.einsum('nbhqk,nbkhd->nbqhd', p, vcat.astype(jnp.float32))
    o = o.reshape(n, m, h, dh)
    lse = jnp.transpose(lse, (0, 1, 3, 2)).reshape(n, m, h)
    return o, lse


def combine_patterns(outs, lses):
    w = jax.nn.softmax(jnp.stack(lses, axis=0), axis=0)
    return jnp.einsum('pbsh,pbshd->bshd', w, jnp.stack(outs, axis=0))


def dilated_prompt(q, k, v):
    b, s, h, dh = q.shape
    outs, lses = [], []
    for window, d in DILATED_PATTERNS:
        span = d * BLOCK
        sp = -(-s // span) * span
        mlen = sp // d
        padw = ((0, 0), (0, sp - s), (0, 0), (0, 0))

        def to_residue(t):
            t = jnp.pad(t, padw).reshape(b, mlen, d, h, dh)
            return jnp.swapaxes(t, 1, 2).reshape(b * d, mlen, h, dh)

        o, l = band_attention(to_residue(q), to_residue(k), to_residue(v), window // d)
        o = jnp.swapaxes(o.reshape(b, d, mlen, h, dh), 1, 2).reshape(b, sp, h, dh)[:, :s]
        l = jnp.swapaxes(l.reshape(b, d, mlen, h), 1, 2).reshape(b, sp, h)[:, :s]
        outs.append(o)
        lses.append(l)
    return combine_patterns(outs, lses).astype(q.dtype)


def dilated_sample(q, k_all, v_all, buf_len):
    t = q.shape[1]
    i = jnp.arange(t)
    outs, lses = [], []
    for window, d in DILATED_PATTERNS:
        j = jnp.arange(window // d + 1)
        idx = buf_len + i[:, None] - j[None, :] * d
        valid = idx >= 0
        idx_c = jnp.clip(idx, 0)
        kg = jnp.take(k_all, idx_c, axis=1)
        vg = jnp.take(v_all, idx_c, axis=1)
        s = jnp.einsum('bthd,btjhd->bhtj', q, kg,
                       preferred_element_type=jnp.float32) * ATTN_SCALE
        s = jnp.where(valid[None, None], s, -jnp.inf)
        l = jax.nn.logsumexp(s, axis=-1)
        p = jnp.exp(s - l[..., None])
        o = jnp.einsum('bhtj,btjhd->bthd', p, vg.astype(jnp.float32))
        outs.append(o)
        lses.append(jnp.swapaxes(l, 1, 2))
    return combine_patterns(outs, lses).astype(q.dtype)


def pool_mix(u_ext, pos, w_pool, pool_scale):
    b, le, c = u_ext.shape
    L = le - POOL_HIST
    uf = u_ext.astype(jnp.float32)
    csum = jnp.concatenate([jnp.zeros((b, 1, c), jnp.float32), jnp.cumsum(uf, axis=1)], axis=1)
    cur = uf[:, POOL_HIST:]
    groups = []
    for g, w in enumerate(POOL_WINDOWS):
        sl = slice(g * POOL_GROUP_WIDTH, (g + 1) * POOL_GROUP_WIDTH)
        win_sum = (csum[:, POOL_HIST + 1:POOL_HIST + 1 + L, sl]
                   - csum[:, POOL_HIST + 1 - w:POOL_HIST + 1 - w + L, sl])
        cnt = jnp.minimum(pos + 1, w).astype(jnp.float32)[None, :, None]
        groups.append(win_sum / cnt - cur[..., sl])
    pooled = jnp.stack(groups, axis=2)
    y = jnp.einsum('blgc,gcd->blgd', pooled, w_pool.astype(jnp.float32)).reshape(b, L, c)
    return (y * pool_scale.astype(jnp.float32)).astype(u_ext.dtype)


def merge(x, attn_o, ga, pool_o, gp, w_out):
    b, s, _ = x.shape
    mix = jnp.concatenate([attn_o.reshape(b, s, ATTN_WIDTH) * jax.nn.silu(ga),
                           pool_o * jax.nn.silu(gp)], axis=-1)
    return x + jnp.einsum('bse,ed->bsd', mix, w_out)


def setup_inputs(seed: int = 0) -> dict:
    key = jax.random.key(seed)
    ks = jax.random.split(key, 12)
    buf = min(MAX_WINDOW, PAST_LEN)
    f32 = jnp.float32
    x_prompt = jax.random.normal(ks[0], (BATCH, SEQ, D_MODEL), f32)
    x_sample = jax.random.normal(ks[1], (DEC_BATCH, DEC_SEQ, D_MODEL), f32)
    cache_k = jax.random.normal(ks[2], (DEPTH, DEC_BATCH, buf, N_HEADS, HEAD_DIM), f32)
    cache_v = jax.random.normal(ks[3], (DEPTH, DEC_BATCH, buf, N_HEADS, HEAD_DIM), f32)
    state_pool = jax.random.normal(ks[4], (DEPTH, DEC_BATCH, POOL_HIST, POOL_WIDTH), f32)
    norm_g = 1.0 + 0.02 * jax.random.normal(ks[5], (DEPTH, D_MODEL), f32)
    w_in = jax.random.normal(ks[6], (DEPTH, D_MODEL, IN_WIDTH), f32) * D_MODEL ** -0.5
    w_pool = jax.random.normal(ks[7], (DEPTH, N_POOL_GROUPS, POOL_GROUP_WIDTH, POOL_GROUP_WIDTH), f32) * POOL_GROUP_WIDTH ** -0.5
    pool_scale = 1.0 + 0.02 * jax.random.normal(ks[8], (DEPTH, POOL_WIDTH), f32)
    w_out = jax.random.normal(ks[9], (DEPTH, MIX_WIDTH, D_MODEL), f32) * MIX_WIDTH ** -0.5
    final_norm_g = 1.0 + 0.02 * jax.random.normal(ks[10], (D_MODEL,), f32)
    return {"x_prompt": x_prompt, "x_sample": x_sample, "cache_k": cache_k, "cache_v": cache_v,
            "state_pool": state_pool, "norm_g": norm_g, "w_in": w_in, "w_pool": w_pool,
            "pool_scale": pool_scale, "w_out": w_out, "final_norm_g": final_norm_g}


def reference(x_prompt, x_sample, cache_k, cache_v, state_pool, norm_g, w_in, w_pool,
              pool_scale, w_out, final_norm_g):
    hp, hs = x_prompt, x_sample
    s = hp.shape[1]
    t = hs.shape[1]
    pos_p = jnp.arange(s)
    pos_s = PAST_LEN + jnp.arange(t)
    buf = cache_k.shape[2]
    keep = min(MAX_WINDOW, s)
    kp, vp, pp, ksn, vsn, psn = [], [], [], [], [], []
    for l in range(DEPTH):
        q, k, v, ga, u, gp = project(hp, norm_g[l], w_in[l])
        a = dilated_prompt(q, k, v)
        u_ext = jnp.pad(u, ((0, 0), (POOL_HIST, 0), (0, 0)))
        po = pool_mix(u_ext, pos_p, w_pool[l], pool_scale[l])
        hp = merge(hp, a, ga, po, gp, w_out[l])
        kp.append(k[:, s - keep:])
        vp.append(v[:, s - keep:])
        pp.append(u_ext[:, -POOL_HIST:])
        q, k, v, ga, u, gp = project(hs, norm_g[l], w_in[l])
        k_all = jnp.concatenate([cache_k[l].astype(k.dtype), k], axis=1)
        v_all = jnp.concatenate([cache_v[l].astype(v.dtype), v], axis=1)
        a = dilated_sample(q, k_all, v_all, buf)
        u_ext = jnp.concatenate([state_pool[l].astype(u.dtype), u], axis=1)
        po = pool_mix(u_ext, pos_s, w_pool[l], pool_scale[l])
        hs = merge(hs, a, ga, po, gp, w_out[l])
        ksn.append(k_all[:, -buf:])
        vsn.append(v_all[:, -buf:])
        psn.append(u_ext[:, -POOL_HIST:])
    y_prompt = rms_norm(hp, final_norm_g)
    y_sample = rms_norm(hs, final_norm_g)
    return (y_prompt, y_sample, jnp.stack(kp), jnp.stack(vp), jnp.stack(pp),
            jnp.stack(ksn), jnp.stack(vsn), jnp.stack(psn))
```

```cpp
#include <hip/hip_runtime.h>
#include <hip/hip_cooperative_groups.h>
#include <cstdio>
#include <cstdint>
namespace cg = cooperative_groups;
#define LAS __attribute__((address_space(3)))
namespace pg8 {
#define PG8_LAS __attribute__((address_space(3)))
typedef unsigned short bf16_t;
typedef short bf16x8 __attribute__((ext_vector_type(8)));
typedef float f32x4 __attribute__((ext_vector_type(4)));
typedef unsigned u32x4 __attribute__((ext_vector_type(4)));
constexpr int BM = 256, BK = 64, HALF = 128, HTB = HALF * BK * 2  , STAGE_BYTES = 8 * HTB, NXCD = 8, WGM = 8;

__host__ __device__ __forceinline__ int lds_byte(int r, int c) { const int st = (r >> 4) * 2 + (c >> 5), rr = r & 15, cc = c & 31, ob = rr * 64 + cc * 2; return st * 1024 + (ob ^ (((ob >> 9) & 1) << 5)); }
__host__ __device__ __forceinline__ void stage_rc(int b, int& R, int& C) { const int st = b / 1024, sb = b % 1024, swz = sb ^ (((sb >> 9) & 1) << 5); R = (st >> 1) * 16 + swz / 64; C = (st & 1) * 32 + (swz % 64) / 2; }
__host__ __device__ __forceinline__ int perm32(int rho) { const int n = rho >> 4, i = rho & 15; return 8 * (i >> 2) + 4 * n + (i & 3); }

struct Unit { int pm, pn; };
struct Gemm { const bf16_t* A; const bf16_t* Bt; int M, N, K; };

struct StaticOrder {
    int nM, nN, nwg, G, c;
    __host__ __device__ void init(int M, int N, int G_, int c_) { nM = M / BM; nN = N / BM; nwg = nM * nN; G = G_; c = c_; }
    __host__ __device__ bool next(int i, Unit& u) const {
        const long L = (long)i * G + c; if (L >= nwg) return false;
        int wgid = (int)L; { const int q = nwg / NXCD, r = nwg % NXCD, xcd = wgid % NXCD, off = wgid / NXCD; wgid = (xcd < r ? xcd * (q + 1) : r * (q + 1) + (xcd - r) * q) + off; }
        const int nig = WGM * nN, gid = wgid / nig, fm = gid * WGM, gsz = (nM - fm) < WGM ? (nM - fm) : WGM;
        u.pm = fm + ((wgid % nig) % gsz); u.pn = (wgid % nig) / gsz; return true;
    }
    __device__ __forceinline__ void a_ready(const Unit&) const {}
    __device__ __forceinline__ void done(const Unit&) const {}
};

__device__ __forceinline__ unsigned cvt_pk_bf16(float lo, float hi) { unsigned r; asm volatile("v_cvt_pk_bf16_f32 %0, %1, %2" : "=v"(r) : "v"(lo), "v"(hi)); return r; }
template <class Epi, class Sched, bool ALIGN_EPI = false, bool SP2 = false>
__device__ __forceinline__ void gemm_phase(PG8_LAS unsigned char* lds, const Gemm g, const Sched& S, const Epi& E, const int tid_in) {
    int tid_ = tid_in; asm volatile("" : "+v"(tid_));
    const int tid = tid_, wid = __builtin_amdgcn_readfirstlane(tid >> 6), lane = tid & 63, wr = wid >> 2, wc = wid & 3, fr = lane & 15, fq = lane >> 4;
    const int K = g.K, nt = K / BK;
    unsigned voffA[2], voffB[2];
#pragma unroll
    for (int i = 0; i < 2; ++i) { int R, C; stage_rc(tid * 16 + i * 8192, R, C); const int Rb = Epi::PERM ? ((R & ~31) + perm32(R & 31)) : R;
        voffA[i] = (unsigned)(R * K + C) * 2u; voffB[i] = (unsigned)(Rb * K + C) * 2u; }
    const size_t kstep = (size_t)(BK * 2);
    const size_t hstep = (size_t)HALF * K * 2;
    const size_t tstep = 2 * hstep;
    const unsigned ldsw = (unsigned)wid * 1024u;
    const int aoff = lds_byte(wr * 64 + fr, fq * 8), boff = lds_byte(wc * 32 + fr, fq * 8);
#define PG8_SA(b, h) (((b) * 2 + (h)) * HTB)
#define PG8_SB(b, h) ((4 + (b) * 2 + (h)) * HTB)
#define PG8_STAGE(bufoff, gbase, voff) do { _Pragma("unroll") for (int _i = 0; _i < 2; ++_i) \
        __builtin_amdgcn_global_load_lds((const unsigned*)((const char*)(gbase) + (voff)[_i]), (PG8_LAS unsigned*)(lds + (bufoff) + ldsw + _i * 8192), 16, 0, 0); } while (0)
#define PG8_LDA(dst, b, h) do { _Pragma("unroll") for (int m = 0; m < 4; ++m) _Pragma("unroll") for (int k = 0; k < 2; ++k) dst[m][k] = *(const PG8_LAS bf16x8*)(lds + PG8_SA(b, h) + aoff + m * 2048 + k * 1024); } while (0)
#define PG8_LDB(dst, b, h) do { _Pragma("unroll") for (int n = 0; n < 2; ++n) _Pragma("unroll") for (int k = 0; k < 2; ++k) dst[n][k] = *(const PG8_LAS bf16x8*)(lds + PG8_SB(b, h) + boff + n * 2048 + k * 1024); } while (0)
#define PG8_MMA(ai, bj, At, Bt) do { __builtin_amdgcn_s_setprio(1); _Pragma("unroll") for (int m = 0; m < 4; ++m) _Pragma("unroll") for (int n = 0; n < 2; ++n) _Pragma("unroll") for (int k = 0; k < 2; ++k) \
        acc[ai][bj][m][n] = __builtin_amdgcn_mfma_f32_16x16x32_bf16(Bt[n][k], At[m][k], acc[ai][bj][m][n], 0, 0, 0); __builtin_amdgcn_s_setprio(0); } while (0)
#define PG8_WAIT_V(n) asm volatile("s_waitcnt vmcnt(" #n ")" ::: "memory")
#define PG8_WAIT_L(n) asm volatile("s_waitcnt lgkmcnt(" #n ")" ::: "memory")
#define PG8_BAR __builtin_amdgcn_s_barrier()
#define PG8_SCHED __builtin_amdgcn_sched_barrier(0)
    Unit cur, nxt; int ui = 0;
    if (!S.next(0, cur)) return;
    f32x4 acc[2][2][4][2];
#pragma unroll
    for (int a = 0; a < 2; ++a)
#pragma unroll
        for (int b = 0; b < 2; ++b)
#pragma unroll
            for (int m = 0; m < 4; ++m)
#pragma unroll
                for (int n = 0; n < 2; ++n) acc[a][b][m][n] = (f32x4){0.f, 0.f, 0.f, 0.f};
    bf16x8 At[4][2], B0[2][2], B1[2][2];
    const char* cA = (const char*)g.A + (size_t)cur.pm * tstep; const char* cB = (const char*)g.Bt + (size_t)cur.pn * tstep;
    S.a_ready(cur);
    if constexpr (SP2) {
        PG8_STAGE(PG8_SB(0, 0), cB, voffB); PG8_STAGE(PG8_SB(0, 1), cB + hstep, voffB); PG8_STAGE(PG8_SA(0, 0), cA, voffA); PG8_STAGE(PG8_SA(0, 1), cA + hstep, voffA);
        if (wr == 1) PG8_BAR;
        PG8_WAIT_V(2); PG8_BAR;
        PG8_STAGE(PG8_SB(1, 0), cB + kstep, voffB); PG8_STAGE(PG8_SA(1, 0), cA + kstep, voffA); PG8_STAGE(PG8_SB(1, 1), cB + hstep + kstep, voffB);
        PG8_WAIT_V(6); PG8_BAR;
    } else {
        PG8_STAGE(PG8_SB(0, 0), cB, voffB); PG8_STAGE(PG8_SA(0, 0), cA, voffA); PG8_STAGE(PG8_SB(0, 1), cB + hstep, voffB); PG8_STAGE(PG8_SA(0, 1), cA + hstep, voffA);
        if (wr == 1) PG8_BAR;
        PG8_WAIT_V(4); PG8_BAR;
        PG8_STAGE(PG8_SB(1, 0), cB + kstep, voffB); PG8_STAGE(PG8_SA(1, 0), cA + kstep, voffA); PG8_STAGE(PG8_SB(1, 1), cB + hstep + kstep, voffB);
        PG8_WAIT_V(6); PG8_BAR;
    }
    for (;;) {
        const bool has_next = S.next(ui + 1, nxt);
        const char* nA = has_next ? (const char*)g.A + (size_t)nxt.pm * tstep : cA; const char* nB = has_next ? (const char*)g.Bt + (size_t)nxt.pn * tstep : cB;
        for (int t = 0; t < nt; t += 2) {
            const bool last = (t == nt - 2);
            const char* a1 = cA + (size_t)(t + 1) * kstep;
            const char* a2 = last ? nA : cA + (size_t)(t + 2) * kstep; const char* b2 = last ? nB : cB + (size_t)(t + 2) * kstep;
            const char* a3 = a2 + kstep; const char* b3 = b2 + kstep;
            if (last && has_next) S.a_ready(nxt);
            if constexpr (SP2) {
            PG8_LDB(B0, 0, 0); PG8_LDB(B1, 0, 1); PG8_SCHED; PG8_LDA(At, 0, 0); PG8_STAGE(PG8_SA(1, 1), a1 + hstep, voffA);
            PG8_WAIT_V(8); PG8_WAIT_L(0); PG8_BAR; PG8_MMA(0, 0, At, B0); PG8_MMA(0, 1, At, B1); PG8_BAR; PG8_SCHED;
            PG8_LDA(At, 0, 1); PG8_STAGE(PG8_SB(0, 0), b2, voffB); PG8_STAGE(PG8_SB(0, 1), b2 + hstep, voffB); PG8_STAGE(PG8_SA(0, 0), a2, voffA);
            PG8_WAIT_V(8); PG8_WAIT_L(0); PG8_BAR; PG8_MMA(1, 0, At, B0); PG8_MMA(1, 1, At, B1); PG8_BAR; PG8_SCHED;
            PG8_LDB(B0, 1, 0); PG8_LDB(B1, 1, 1); PG8_SCHED; PG8_LDA(At, 1, 0); PG8_STAGE(PG8_SA(0, 1), a2 + hstep, voffA);
            PG8_WAIT_V(8); PG8_WAIT_L(0); PG8_BAR; PG8_MMA(0, 0, At, B0); PG8_MMA(0, 1, At, B1); PG8_BAR; PG8_SCHED;
            PG8_LDA(At, 1, 1); PG8_STAGE(PG8_SB(1, 0), b3, voffB); PG8_STAGE(PG8_SB(1, 1), b3 + hstep, voffB); PG8_STAGE(PG8_SA(1, 0), a3, voffA);
            PG8_WAIT_V(8); PG8_WAIT_L(0); PG8_BAR; PG8_MMA(1, 0, At, B0); PG8_MMA(1, 1, At, B1); PG8_BAR; PG8_SCHED;
            } else {
            PG8_LDB(B0, 0, 0); PG8_SCHED; PG8_LDA(At, 0, 0); PG8_STAGE(PG8_SA(1, 1), a1 + hstep, voffA);
            PG8_WAIT_L(8); PG8_BAR; PG8_WAIT_L(0); PG8_MMA(0, 0, At, B0); PG8_BAR; PG8_SCHED;
            PG8_LDB(B1, 0, 1); PG8_STAGE(PG8_SB(0, 0), b2, voffB);
            PG8_BAR; PG8_WAIT_L(0); PG8_MMA(0, 1, At, B1); PG8_BAR;
            PG8_LDA(At, 0, 1); PG8_STAGE(PG8_SA(0, 0), a2, voffA);
            PG8_BAR; PG8_WAIT_L(0); PG8_MMA(1, 0, At, B0); PG8_BAR; PG8_SCHED;
            PG8_STAGE(PG8_SB(0, 1), b2 + hstep, voffB);
            PG8_WAIT_V(6); PG8_BAR; PG8_MMA(1, 1, At, B1); PG8_BAR;
            PG8_LDB(B0, 1, 0); PG8_SCHED; PG8_LDA(At, 1, 0); PG8_STAGE(PG8_SA(0, 1), a2 + hstep, voffA);
            PG8_WAIT_L(8); PG8_BAR; PG8_WAIT_L(0); PG8_MMA(0, 0, At, B0); PG8_BAR; PG8_SCHED;
            PG8_LDB(B1, 1, 1); PG8_STAGE(PG8_SB(1, 0), b3, voffB);
            PG8_BAR; PG8_WAIT_L(0); PG8_MMA(0, 1, At, B1); PG8_BAR;
            PG8_LDA(At, 1, 1); PG8_STAGE(PG8_SA(1, 0), a3, voffA);
            PG8_BAR; PG8_WAIT_L(0); PG8_MMA(1, 0, At, B0); PG8_BAR; PG8_SCHED;
            PG8_STAGE(PG8_SB(1, 1), b3 + hstep, voffB);
            PG8_WAIT_V(6); PG8_BAR; PG8_MMA(1, 1, At, B1); PG8_BAR;
            }
        }
        if constexpr (ALIGN_EPI) { if (wr == 0) PG8_BAR; }
        if constexpr (!Epi::AFTER_DRAIN) { E(acc, cur, wr, wc, fr, fq); S.done(cur); }
        if (!has_next) break;
#pragma unroll
        for (int a = 0; a < 2; ++a)
#pragma unroll
            for (int b = 0; b < 2; ++b)
#pragma unroll
                for (int m = 0; m < 4; ++m)
#pragma unroll
                    for (int n = 0; n < 2; ++n) acc[a][b][m][n] = (f32x4){0.f, 0.f, 0.f, 0.f};
        cur = nxt; cA = nA; cB = nB; ++ui;
        if constexpr (ALIGN_EPI) { if (wr == 1) PG8_BAR; }
    }
    PG8_WAIT_V(0);
    if constexpr (!ALIGN_EPI) { if (wr == 0) PG8_BAR; }
    PG8_BAR;
    if constexpr (Epi::AFTER_DRAIN) { E.fused(acc, cur, wr, wc, fr, fq, lds, wid, lane); S.done(cur); }
#undef PG8_SA
#undef PG8_SB
#undef PG8_STAGE
#undef PG8_LDA
#undef PG8_LDB
#undef PG8_MMA
#undef PG8_WAIT_V
#undef PG8_WAIT_L
#undef PG8_BAR
#undef PG8_SCHED
}
}
#define XB_TMO      128
#define XB_XCNT(j)  (256  + 64 * (j))
#define XB_XSUB(j)  (1280 + 64 * (j))
#define XB_XGEN(j)  (2304 + 64 * (j))
#define XB_TOP      3328
#define XB_TOPGEN   3392
#define XCD_BAR_WORDS 3456
#define XB_SPIN_CAP (1u << 18)

__device__ __forceinline__ unsigned xb_ld(unsigned* p)              { return __hip_atomic_load(p, __ATOMIC_RELAXED, __HIP_MEMORY_SCOPE_AGENT); }
__device__ __forceinline__ unsigned xb_add(unsigned* p, unsigned v) { return __hip_atomic_fetch_add(p, v, __ATOMIC_RELAXED, __HIP_MEMORY_SCOPE_AGENT); }
__device__ __forceinline__ unsigned xb_xcc_id() { return (unsigned)__builtin_amdgcn_s_getreg((3 << 11) | 20) & 0xFu; }
#define XB_SPIN(cond, bar) do { unsigned _sp = 0; while (cond) { __builtin_amdgcn_s_sleep(1); \
    if ((++_sp & 255u) == 0u) { if (xb_ld(&(bar)[XB_TMO])) break; if (_sp > XB_SPIN_CAP) { atomicAdd(&(bar)[XB_TMO], 1u); break; } } } } while (0)

struct XcdBarrier {
    unsigned* bar; unsigned x;
    volatile LAS unsigned* st;
};

__device__ __forceinline__ XcdBarrier xcd_barrier_post(unsigned* bar, volatile LAS unsigned* st) {
    XcdBarrier b; b.bar = bar; b.x = xb_xcc_id(); b.st = st;
    if (threadIdx.x == 0) (void)xb_add(&bar[XB_XCNT(b.x)], 1u);
    return b;
}
__device__ __forceinline__ void xcd_barrier_complete(unsigned* bar, unsigned x, unsigned& nloc, unsigned& nx) {
    const unsigned G = gridDim.x * gridDim.y * gridDim.z;
    unsigned sum, cnt, mine, sp = 0u;
    for (;;) {
        sum = 0u; cnt = 0u; mine = 0u;
#pragma unroll
        for (unsigned j = 0; j < 16; ++j) { const unsigned c = xb_ld(&bar[XB_XCNT(j)]); sum += c; cnt += (c > 0u) ? 1u : 0u; mine = (j == x) ? c : mine; }
        if (sum == G) break;
        __builtin_amdgcn_s_sleep(1);
        if ((++sp & 255u) == 0u) { if (xb_ld(&bar[XB_TMO])) break; if (sp > XB_SPIN_CAP) { atomicAdd(&bar[XB_TMO], 1u); break; } }
    }
    nloc = mine > 0u ? mine : 1u; nx = cnt > 0u ? cnt : 1u;
}

__device__ __forceinline__ void xcd_barrier(const XcdBarrier& b) {
    asm volatile("s_waitcnt vmcnt(0)" ::: "memory");
    __syncthreads();
    if (threadIdx.x == 0) {
        unsigned* bar = b.bar;
        __builtin_amdgcn_s_waitcnt(0);
        unsigned nloc = b.st[0], nx = b.st[1];
        if (nloc == 0u) { xcd_barrier_complete(bar, b.x, nloc, nx); b.st[0] = nloc; b.st[1] = nx; }
        const unsigned old = xb_add(&bar[XB_XSUB(b.x)], 1u);
        const unsigned gen = old / nloc;
        if (old + 1u == (gen + 1u) * nloc) {
            __builtin_amdgcn_fence(__ATOMIC_RELEASE, "agent");
            asm volatile("s_waitcnt vmcnt(0)" ::: "memory");
            const unsigned og = xb_add(&bar[XB_TOP], 1u);
            const unsigned tg = og / nx;
            if (og + 1u == (tg + 1u) * nx) xb_add(&bar[XB_TOPGEN], 1u);
            else XB_SPIN(xb_ld(&bar[XB_TOPGEN]) == tg, bar);
            __builtin_amdgcn_fence(__ATOMIC_ACQUIRE, "agent");
            xb_add(&bar[XB_XGEN(b.x)], 1u);
            asm volatile("s_waitcnt vmcnt(0)" ::: "memory");
        } else {
            XB_SPIN(xb_ld(&bar[XB_XGEN(b.x)]) == gen, bar);
            __builtin_amdgcn_fence(__ATOMIC_ACQUIRE, "agent");
            asm volatile("s_waitcnt vmcnt(0)" ::: "memory");
        }
    }
    __syncthreads();
}

typedef unsigned short bf16_t;
typedef short bf16x8 __attribute__((ext_vector_type(8)));
typedef float f32x4 __attribute__((ext_vector_type(4)));
typedef float f32x16 __attribute__((ext_vector_type(16)));
typedef unsigned u32x4 __attribute__((ext_vector_type(4)));
typedef unsigned u32x2 __attribute__((ext_vector_type(2)));

constexpr int DM = 2048, SEQ = 4096, NB = 2, MP = NB * SEQ  , MS = 32  , MT = MP + MS;
constexpr int INW = 6144, AW = 1024, NH = 16, HD = 64, BUF = 2048, DB = 8, DT = 4, PH = 15, PW = 1024;
constexpr int C_Q = 0, C_K = 1024, C_V = 2048, C_GA = 3072, C_U = 4096, C_GP = 5120;
constexpr float EPS = 1e-6f;
constexpr float LOG2E = 1.4426950408889634f;

constexpr size_t O_YP = 0, O_YS = 16777216, O_KP = 16842752, O_VP = 21037056, O_PP = 25231360, O_KS = 25262080, O_VS = 42039296, O_PS = 58816512;

constexpr size_t MiB = 1u << 20;
constexpr size_t WS_CNT = 0  , WS_BAR = 65536, CTL_ZERO_BYTES = 131072, WS_SLOTS = 1 * MiB  , WS_WIN = 2 * MiB, WS_WOUT = 26 * MiB, WS_WPOOL = 34 * MiB, WS_XN = 36 * MiB, WS_Z = 70 * MiB, WS_MIX = 168 * MiB,
                 WS_POOLED = 202 * MiB, WS_POOLEDS = 219 * MiB, WS_KC = 220 * MiB, WS_VC = 238 * MiB;

constexpr int LDS_BYTES = 155648;
#ifndef PHM
#define PHM 63
#endif
#ifndef PHDUP
#define PHDUP 0
#endif
#ifndef SYNCDUP
#define SYNCDUP 1
#endif
#define GRID_SYNC() do { for (int s_ = 0; s_ < SYNCDUP; ++s_) xcd_barrier(xbar); } while (0)

struct Args {
    const float* x_prompt; const float* x_sample; const float* cache_k; const float* cache_v; const float* state_pool;
    const float* norm_g; const float* w_in; const float* w_pool; const float* pool_scale; const float* w_out; const float* final_g;
    float* out; unsigned char* ws;
};

__device__ __forceinline__ int otid(int wave_s) { int l; asm volatile("v_mbcnt_lo_u32_b32 %0, -1, 0\n\tv_mbcnt_hi_u32_b32 %0, -1, %0" : "=v"(l)); return wave_s * 64 + l; }
__device__ __forceinline__ int osgpr(int v) { asm volatile("" : "+s"(v)); return v; }
__device__ __forceinline__ unsigned f2bf(float f) { unsigned u = __builtin_bit_cast(unsigned, f); return (u + 0x7fffu + ((u >> 16) & 1u)) >> 16; }
typedef float f32x2_t __attribute__((ext_vector_type(2))); typedef __bf16 bf16x2_t __attribute__((ext_vector_type(2)));
__device__ __forceinline__ unsigned pk2(float lo, float hi) { f32x2_t v = {lo, hi}; bf16x2_t b = __builtin_convertvector(v, bf16x2_t); return __builtin_bit_cast(unsigned, b); }
__device__ __forceinline__ float bflo(unsigned w) { return __builtin_bit_cast(float, w << 16); }
__device__ __forceinline__ float bfhi(unsigned w) { return __builtin_bit_cast(float, w & 0xffff0000u); }
__device__ __forceinline__ float silu(float v) { return v * __builtin_amdgcn_rcpf(1.f + __builtin_amdgcn_exp2f(-1.4426950408889634f * v)); }
__device__ __forceinline__ float wave_sum(float v) {
#pragma unroll
    for (int o = 1; o < 64; o <<= 1) v += __shfl_xor(v, o);
    return v;
}
__device__ __forceinline__ float wave_max(float v) {
#pragma unroll
    for (int o = 1; o < 64; o <<= 1) v = fmaxf(v, __shfl_xor(v, o));
    return v;
}

__device__ __forceinline__ void p0_transpose_item(const float* W, int K, int N, bf16_t* WT, LAS float* scr, int item, int lane) {
    const int nblk = N / 32, kb = item / nblk, nb = item % nblk, k0 = 64 * kb, n0 = 32 * nb;
    f32x4 v[8];
#pragma unroll
    for (int i = 0; i < 8; ++i) v[i] = __builtin_nontemporal_load((const f32x4*)(W + (size_t)(k0 + 8 * i + (lane >> 3)) * N + n0 + 4 * (lane & 7)));
#pragma unroll
    for (int i = 0; i < 8; ++i) { LAS float* d = scr + (8 * i + (lane >> 3)) * 33 + 4 * (lane & 7); d[0] = v[i].x; d[1] = v[i].y; d[2] = v[i].z; d[3] = v[i].w; }
    asm volatile("s_waitcnt lgkmcnt(0)" ::: "memory");
    const int c = lane & 7;
#pragma unroll
    for (int j = 0; j < 4; ++j) { const int n = (lane >> 3) + 8 * j; const LAS float* s = scr + (8 * c) * 33 + n;
        u32x4 o; o.x = pk2(s[0 * 33], s[1 * 33]); o.y = pk2(s[2 * 33], s[3 * 33]); o.z = pk2(s[4 * 33], s[5 * 33]); o.w = pk2(s[6 * 33], s[7 * 33]);
        *(u32x4*)(WT + (size_t)(n0 + n) * K + k0 + 8 * c) = o; }
    asm volatile("s_waitcnt lgkmcnt(0)" ::: "memory");
}

__device__ __forceinline__ void rms_row_to_bf16(const float* xrow, const float* g, bf16_t* orow, int lane) {
    const f32x4* xr = (const f32x4*)xrow + lane; const f32x4* gr = (const f32x4*)g + lane;
    f32x4 v[8]; float s = 0.f;
#pragma unroll
    for (int j = 0; j < 8; ++j) { v[j] = __builtin_nontemporal_load(xr + 64 * j); s += (v[j].x * v[j].x + v[j].y * v[j].y) + (v[j].z * v[j].z + v[j].w * v[j].w); }
    const float rs = 1.f / sqrtf(wave_sum(s) * (1.f / DM) + EPS);
    u32x2* o8 = (u32x2*)orow + lane;
#pragma unroll
    for (int j = 0; j < 8; ++j) { const f32x4 gg = gr[64 * j]; u32x2 w; w.x = pk2(v[j].x * rs * gg.x, v[j].y * rs * gg.y); w.y = pk2(v[j].z * rs * gg.z, v[j].w * rs * gg.w); o8[64 * j] = w; }
}

struct EpiZ {
    static constexpr bool PERM = true, AFTER_DRAIN = false;
    bf16_t* Z; float* out; bf16_t* KC; bf16_t* VC;
    __device__ __forceinline__ void operator()(const pg8::f32x4 (&acc)[2][2][4][2], const pg8::Unit& u, int wr, int wc, int fr_, int fq_) const {
        int l_ = (fq_ << 4) | fr_; asm volatile("" : "+v"(l_)); const int fr = l_ & 15, fq = l_ >> 4;
        const int row0 = u.pm * 256 + wr * 64 + fr, col0 = u.pn * 256 + wc * 32 + 8 * fq;
        const int b = u.pm >> 4, pt = u.pm & 15;
        float* fo = nullptr;
        if (pt >= 8) { if (u.pn >= 4 && u.pn < 8) fo = out + O_KP + (col0 - C_K); else if (u.pn >= 8 && u.pn < 12) fo = out + O_VP + (col0 - C_V); }
        const bool pool = (pt == 15) && (u.pn >= 16) && (u.pn < 20);
        bf16_t* cz = nullptr; int ck0 = 0;
        if (u.pn >= 4 && u.pn < 8) { cz = KC; ck0 = col0 - C_K; } else if (u.pn >= 8 && u.pn < 12) { cz = VC; ck0 = col0 - C_V; }
#pragma unroll
        for (int ai = 0; ai < 2; ++ai)
#pragma unroll
            for (int m = 0; m < 4; ++m) {
                const int row = row0 + ai * 128 + m * 16; const int pos = row & (SEQ - 1);
                bf16_t* rowp = Z + (size_t)row * INW + col0;
#pragma unroll
                for (int bj = 0; bj < 2; ++bj) {
                    const pg8::f32x4 v0 = acc[ai][bj][m][0], v1 = acc[ai][bj][m][1];
                    u32x4 w; w.x = pk2(v0[0], v0[1]); w.y = pk2(v0[2], v0[3]); w.z = pk2(v1[0], v1[1]); w.w = pk2(v1[2], v1[3]);
                    if (cz) { const int ck = ck0 + bj * 128; *(u32x4*)(cz + (((size_t)(b * NH + (ck >> 6)) * SEQ + pos) * HD + (ck & 63))) = w; }
                    else *(u32x4*)(rowp + bj * 128) = w;
                    if (fo) { float* p = fo + (size_t)(b * BUF + pos - BUF) * AW + bj * 128; *(pg8::f32x4*)p = v0; *(pg8::f32x4*)(p + 4) = v1; }
                    if (pool && pos >= SEQ - PH) { float* p = out + O_PP + (size_t)(b * PH + pos - (SEQ - PH)) * PW + (col0 - C_U) + bj * 128; *(pg8::f32x4*)p = v0; *(pg8::f32x4*)(p + 4) = v1; }
                }
            }
    }
};

#define NORM_SPIN_CAP (1u << 22)
struct EpiYN {
    static constexpr bool PERM = false, AFTER_DRAIN = true;
    const float* x; float* y; const float* gfin; float* slots; unsigned* cnt;
    __device__ __forceinline__ void fused(pg8::f32x4 (&acc)[2][2][4][2], const pg8::Unit& u, int wr, int wc, int fr, int fq, LAS unsigned char* lds, int wid, int lane) const {
        LAS float* P = (LAS float*)lds;
        LAS float* S = (LAS float*)(lds + 4096);
        const int row0 = u.pm * 256 + wr * 64 + fr, col0 = u.pn * 256 + wc * 32 + 4 * fq;
#pragma unroll
        for (int ai = 0; ai < 2; ++ai)
#pragma unroll
            for (int m = 0; m < 4; ++m) {
                const int row = row0 + ai * 128 + m * 16; float ss = 0.f;
#pragma unroll
                for (int bj = 0; bj < 2; ++bj)
#pragma unroll
                    for (int n = 0; n < 2; ++n) {
                        const f32x4 xv = *(const f32x4*)(x + (size_t)row * DM + col0 + bj * 128 + n * 16);
                        pg8::f32x4 hv = acc[ai][bj][m][n]; hv[0] += xv.x; hv[1] += xv.y; hv[2] += xv.z; hv[3] += xv.w; acc[ai][bj][m][n] = hv;
                        ss += (hv[0] * hv[0] + hv[1] * hv[1]) + (hv[2] * hv[2] + hv[3] * hv[3]);
                    }
                ss += __shfl_xor(ss, 16); ss += __shfl_xor(ss, 32);
                if (fq == 0) P[(ai * 128 + wr * 64 + m * 16 + fr) * 4 + wc] = ss;
                if (m & 1) asm volatile("" ::: "memory");
            }
        asm volatile("s_waitcnt lgkmcnt(0)" ::: "memory"); __builtin_amdgcn_s_barrier(); asm volatile("" ::: "memory");
        const int t = wid * 64 + lane;
        if (t < 256) { const float s = (P[t * 4] + P[t * 4 + 1]) + (P[t * 4 + 2] + P[t * 4 + 3]);
            __hip_atomic_store(slots + (size_t)(u.pm * 256 + t) * 8 + u.pn, s, __ATOMIC_RELAXED, __HIP_MEMORY_SCOPE_AGENT); }
        asm volatile("s_waitcnt vmcnt(0)" ::: "memory");
        if (t < 256 && lane == 0) __hip_atomic_fetch_add(cnt + 64 * u.pm, 1u, __ATOMIC_RELAXED, __HIP_MEMORY_SCOPE_AGENT);
        if (wid == 0) { unsigned sp = 0;
            while ((unsigned)__builtin_amdgcn_readfirstlane(__hip_atomic_load(cnt + 64 * u.pm, __ATOMIC_RELAXED, __HIP_MEMORY_SCOPE_AGENT)) < 32u) { __builtin_amdgcn_s_sleep(2); if (++sp > NORM_SPIN_CAP) break; }
            __builtin_amdgcn_fence(__ATOMIC_ACQUIRE, "agent"); }
        asm volatile("s_waitcnt vmcnt(0) lgkmcnt(0)" ::: "memory"); __builtin_amdgcn_s_barrier(); asm volatile("" ::: "memory");
        if (t < 256) { const float* sl = slots + (size_t)(u.pm * 256 + t) * 8; float tot = 0.f;
#pragma unroll
            for (int k = 0; k < 8; ++k) tot += __hip_atomic_load(sl + k, __ATOMIC_RELAXED, __HIP_MEMORY_SCOPE_AGENT);
            S[t] = 1.f / sqrtf(tot * (1.f / DM) + EPS); }
        asm volatile("s_waitcnt vmcnt(0) lgkmcnt(0)" ::: "memory"); __builtin_amdgcn_s_barrier(); asm volatile("" ::: "memory");
        f32x4 gg[2][2];
#pragma unroll
        for (int bj = 0; bj < 2; ++bj)
#pragma unroll
            for (int n = 0; n < 2; ++n) gg[bj][n] = *(const f32x4*)(gfin + col0 + bj * 128 + n * 16);
#pragma unroll
        for (int ai = 0; ai < 2; ++ai)
#pragma unroll
            for (int m = 0; m < 4; ++m) {
                const int rl = ai * 128 + wr * 64 + m * 16 + fr; const float rs = S[rl]; const int row = u.pm * 256 + rl;
#pragma unroll
                for (int bj = 0; bj < 2; ++bj)
#pragma unroll
                    for (int n = 0; n < 2; ++n) { const pg8::f32x4 hv = acc[ai][bj][m][n]; f32x4 o; o.x = hv[0] * rs * gg[bj][n].x; o.y = hv[1] * rs * gg[bj][n].y; o.z = hv[2] * rs * gg[bj][n].z; o.w = hv[3] * rs * gg[bj][n].w;
                        *(f32x4*)(y + (size_t)row * DM + col0 + bj * 128 + n * 16) = o; }
            }
    }
};

template <class Epi>
__device__ __forceinline__ void small_gemm(LAS unsigned char* lds, const bf16_t* A, const bf16_t* Bt, int ntiles, int K, int tile0, int tstride, const Epi& E, const int tid) {
    const int  wid = tid >> 6, lane = tid & 63, fr = lane & 15, fq = lane >> 4;
    LAS float* red = (LAS float*)lds;
    const int kw = K >> 3, k0 = wid * kw;
    for (int tile = tile0; tile < ntiles; tile += tstride) {
        const int n0 = tile * 32;
        f32x4 acc[2][2];
#pragma unroll
        for (int a = 0; a < 2; ++a)
#pragma unroll
            for (int b = 0; b < 2; ++b) acc[a][b] = (f32x4){0.f, 0.f, 0.f, 0.f};
        const bf16_t* ap = A + (size_t)fr * K + k0 + fq * 8;
        const bf16_t* bp = Bt + (size_t)(n0 + fr) * K + k0 + fq * 8;
#pragma unroll 4
        for (int kk = 0; kk < kw; kk += 32) {
            const bf16x8 a0 = *(const bf16x8*)(ap + kk), a1 = *(const bf16x8*)(ap + (size_t)16 * K + kk);
            const bf16x8 b0 = *(const bf16x8*)(bp + kk), b1 = *(const bf16x8*)(bp + (size_t)16 * K + kk);
            acc[0][0] = __builtin_amdgcn_mfma_f32_16x16x32_bf16(a0, b0, acc[0][0], 0, 0, 0);
            acc[0][1] = __builtin_amdgcn_mfma_f32_16x16x32_bf16(a0, b1, acc[0][1], 0, 0, 0);
            acc[1][0] = __builtin_amdgcn_mfma_f32_16x16x32_bf16(a1, b0, acc[1][0], 0, 0, 0);
            acc[1][1] = __builtin_amdgcn_mfma_f32_16x16x32_bf16(a1, b1, acc[1][1], 0, 0, 0);
        }
#pragma unroll
        for (int mi = 0; mi < 2; ++mi)
#pragma unroll
            for (int ni = 0; ni < 2; ++ni)
#pragma unroll
                for (int j = 0; j < 4; ++j) red[wid * 1024 + (mi * 16 + fq * 4 + j) * 32 + ni * 16 + fr] = acc[mi][ni][j];
        __syncthreads();
#pragma unroll
        for (int k = 0; k < 2; ++k) { const int e = tid + 512 * k; float s = 0.f;
#pragma unroll
            for (int w = 0; w < 8; ++w) s += red[w * 1024 + e];
            E(e >> 5, n0 + (e & 31), s); }
        __syncthreads();
    }
}
struct SEpiZ {
    bf16_t* Z; float* out;
    __device__ __forceinline__ void operator()(int row, int col, float v) const {
        Z[(size_t)(MP + row) * INW + col] = (bf16_t)f2bf(v);
        const int b = row >> 2, t = row & 3;
        if (col >= C_K && col < C_V) out[O_KS + (size_t)(b * BUF + BUF - DT + t) * AW + (col - C_K)] = v;
        else if (col >= C_V && col < C_GA) out[O_VS + (size_t)(b * BUF + BUF - DT + t) * AW + (col - C_V)] = v;
        else if (col >= C_U && col < C_GP) out[O_PS + (size_t)(b * PH + PH - DT + t) * PW + (col - C_U)] = v;
    }
};
__device__ __forceinline__ void sample_out_unit(LAS unsigned char* lds, const bf16_t* A, const bf16_t* Bt, const float* xs, float* ys, const float* gfin, float* slots, unsigned* cnt, int tile, int tid) {
    const int wid = tid >> 6, lane = tid & 63, fr = lane & 15, fq = lane >> 4;
    LAS float* red = (LAS float*)lds;
    LAS float* S = (LAS float*)(lds + 32768);
    constexpr int K = DM; const int kw = K >> 3, k0 = wid * kw, n0 = tile * 32;
    f32x4 acc[2][2];
#pragma unroll
    for (int a = 0; a < 2; ++a)
#pragma unroll
        for (int b = 0; b < 2; ++b) acc[a][b] = (f32x4){0.f, 0.f, 0.f, 0.f};
    const bf16_t* ap = A + (size_t)fr * K + k0 + fq * 8;
    const bf16_t* bp = Bt + (size_t)(n0 + fr) * K + k0 + fq * 8;
#pragma unroll 4
    for (int kk = 0; kk < kw; kk += 32) {
        const bf16x8 a0 = *(const bf16x8*)(ap + kk), a1 = *(const bf16x8*)(ap + (size_t)16 * K + kk);
        const bf16x8 b0 = *(const bf16x8*)(bp + kk), b1 = *(const bf16x8*)(bp + (size_t)16 * K + kk);
        acc[0][0] = __builtin_amdgcn_mfma_f32_16x16x32_bf16(a0, b0, acc[0][0], 0, 0, 0);
        acc[0][1] = __builtin_amdgcn_mfma_f32_16x16x32_bf16(a0, b1, acc[0][1], 0, 0, 0);
        acc[1][0] = __builtin_amdgcn_mfma_f32_16x16x32_bf16(a1, b0, acc[1][0], 0, 0, 0);
        acc[1][1] = __builtin_amdgcn_mfma_f32_16x16x32_bf16(a1, b1, acc[1][1], 0, 0, 0);
    }
#pragma unroll
    for (int mi = 0; mi < 2; ++mi)
#pragma unroll
        for (int ni = 0; ni < 2; ++ni)
#pragma unroll
            for (int j = 0; j < 4; ++j) red[wid * 1024 + (mi * 16 + fq * 4 + j) * 32 + ni * 16 + fr] = acc[mi][ni][j];
    __syncthreads();
    float hv[2];
#pragma unroll
    for (int k = 0; k < 2; ++k) { const int e = tid + 512 * k, row = e >> 5, col = n0 + (e & 31); float s = 0.f;
#pragma unroll
        for (int w = 0; w < 8; ++w) s += red[w * 1024 + e];
        const float h = xs[(size_t)row * DM + col] + s; hv[k] = h;
        float ss = h * h;
#pragma unroll
        for (int o = 1; o < 32; o <<= 1) ss += __shfl_xor(ss, o);
        if ((lane & 31) == 0) __hip_atomic_store(slots + row * 64 + tile, ss, __ATOMIC_RELAXED, __HIP_MEMORY_SCOPE_AGENT); }
    asm volatile("s_waitcnt vmcnt(0)" ::: "memory");
    __syncthreads();
    if (tid == 0) { __hip_atomic_fetch_add(cnt, 1u, __ATOMIC_RELAXED, __HIP_MEMORY_SCOPE_AGENT); }
    if (wid == 0) { unsigned sp = 0;
        while ((unsigned)__builtin_amdgcn_readfirstlane(__hip_atomic_load(cnt, __ATOMIC_RELAXED, __HIP_MEMORY_SCOPE_AGENT)) < 64u) { __builtin_amdgcn_s_sleep(2); if (++sp > NORM_SPIN_CAP) break; }
        __builtin_amdgcn_fence(__ATOMIC_ACQUIRE, "agent");
        if (lane < 32) { float tot = 0.f;
#pragma unroll 8
            for (int k = 0; k < 64; ++k) tot += __hip_atomic_load(slots + lane * 64 + k, __ATOMIC_RELAXED, __HIP_MEMORY_SCOPE_AGENT);
            S[lane] = 1.f / sqrtf(tot * (1.f / DM) + EPS); } }
    __syncthreads();
#pragma unroll
    for (int k = 0; k < 2; ++k) { const int e = tid + 512 * k, row = e >> 5, col = n0 + (e & 31);
        ys[(size_t)row * DM + col] = hv[k] * S[row] * gfin[col]; }
    __syncthreads();
}

constexpr int CP_PER_B = (BUF - DT) * AW / 4, CP_N = DB * CP_PER_B, CP_ATT = 256 * 8 * 6 * 512  ;
__device__ __forceinline__ void cp_addr(const Args& a, int i, const f32x4*& src, f32x4*& dst) {
    const bool isv = i >= CP_N; const int ii = isv ? i - CP_N : i; const int b = ii / CP_PER_B, o = ii - b * CP_PER_B;
    const size_t d = (size_t)b * (BUF * AW / 4) + o;
    src = (const f32x4*)(isv ? a.cache_v : a.cache_k) + d + DT * AW / 4;
    dst = (f32x4*)(a.out + (isv ? O_VS : O_KS)) + d;
}

typedef short s16x4 __attribute__((ext_vector_type(4)));
__device__ __forceinline__ s16x4 vtr(const LAS unsigned char* p) { return __builtin_bit_cast(s16x4, __builtin_amdgcn_ds_read_tr16_b64_v4i16((LAS s16x4*)p)); }
__device__ __forceinline__ int crow(int r, int hi) { return (r & 3) + 8 * (r >> 2) + 4 * hi; }
constexpr int OSH_STRIDE = 144, OSH_BYTES = 512 * OSH_STRIDE  , LSH_OFF = OSH_BYTES, VSH_OFF = LSH_OFF + 2048, VSH_WAVE = 32 * 144  ;
constexpr int KSH2_OFF = VSH_OFF + 8 * VSH_WAVE  ;
static_assert(KSH2_OFF + 8 * VSH_WAVE <= LDS_BYTES - 64, "attention LDS map");

__device__ __forceinline__ void attn_prompt_unit(LAS unsigned char* lds, const bf16_t* Z, bf16_t* MIX, int b, int h, int blk, const int wid  , const Args& a, const int unit, const bf16_t* KC, const bf16_t* VC) {
    LAS unsigned char* Osh = lds;
    LAS float* Lsh = (LAS float*)(lds + LSH_OFF);
    LAS unsigned char* Vsh = lds + VSH_OFF + wid * VSH_WAVE;
    const int t0 = blk * 512; const size_t rowbase = (size_t)b * SEQ;
    const char* Kb = (const char*)KC + (size_t)(b * NH + h) * SEQ * (HD * 2); const char* Vb = (const char*)VC + (size_t)(b * NH + h) * SEQ * (HD * 2);
    const float SC = 0.125f * LOG2E;
#pragma unroll 1
    for (int p = 0; p < 3; ++p) {
        const int dil = 1 << (2 * p);
#pragma unroll 1
        for (int gi = 0; gi < 2; ++gi) {
            const int g = wid * 2 + gi;
            const int lane = otid(0); const int r = lane & 31, hh = lane >> 5;
            const int cpbase = (((unit * 8 + wid) * 6) + (p * 2 + gi)) * 512; f32x4 cpv[4]; unsigned cpo[4];
            const bool cp_isv = cpbase >= CP_N; const int cp_ii0 = cp_isv ? cpbase - CP_N : cpbase, cp_vb0 = cp_ii0 / CP_PER_B, cp_next = (cp_vb0 + 1) * CP_PER_B;
            const char* cp_src = (const char*)(cp_isv ? a.cache_v : a.cache_k) + (size_t)DT * AW * 4; char* cp_dst = (char*)(a.out + (cp_isv ? O_VS : O_KS));
#define CP_OFF(K_) ({ const int ii_ = cp_ii0 + (K_) + lane; (unsigned)(ii_ + (ii_ >= cp_next ? cp_vb0 + 1 : cp_vb0) * 1024) * 16u; })
            const char* Zb = (const char*)Z; constexpr unsigned ROWB = INW * 2; const unsigned rb0 = (unsigned)rowbase;
            const LAS unsigned char* vtb = Vsh + (4 * hh + ((lane & 15) >> 2)) * 144 + (16 * ((lane >> 4) & 1) + 4 * (lane & 3)) * 2;
            const int qbase = t0 + (g & (dil - 1)) + dil * 32 * (g >> (2 * p));
            const int qpos = qbase + dil * r;
            const unsigned qoff = (rb0 + (unsigned)qpos) * ROWB + (unsigned)((C_Q + h * HD + hh * 8) * 2);
            bf16x8 bq[4];
#pragma unroll
            for (int s = 0; s < 4; ++s) bq[s] = *(const bf16x8*)(Zb + (size_t)qoff + 32 * s);
            f32x16 X[5];
            {
                u32x4 kr[5][4];
                const int ka0 = qbase + dil * ((lane >> 3) - 128);
                const unsigned kcolb = (unsigned)((C_K + h * HD + (lane & 7) * 8) * 2);
#pragma unroll
                for (int T = 0; T < 5; ++T)
#pragma unroll
                    for (int c = 0; c < 4; ++c) { const int kpos = ka0 + (32 * T + 8 * c) * dil;
                        kr[T][c] = *(const u32x4*)(Kb + (size_t)((unsigned)(kpos < 0 ? 0 : kpos) * 128u + (unsigned)((lane & 7) * 16))); }
#pragma unroll
                for (int u = 0; u < 4; ++u) { cpo[u] = CP_OFF(64 * u); cpv[u] = __builtin_nontemporal_load((const f32x4*)(cp_src + (size_t)cpo[u])); }
                __builtin_amdgcn_sched_barrier(0);
                LAS unsigned char* Ksh2 = lds + KSH2_OFF + wid * VSH_WAVE;
#pragma unroll
                for (int T = 0; T < 5; ++T) {
                    LAS unsigned char* kb = (T & 1) ? Ksh2 : Vsh;
#pragma unroll
                    for (int c = 0; c < 4; ++c) *(LAS u32x4*)(kb + ((lane >> 3) + 8 * c) * 144 + (lane & 7) * 16) = kr[T][c];
                    f32x16 x;
#pragma unroll
                    for (int i = 0; i < 16; ++i) x[i] = 0.f;
#pragma unroll
                    for (int s = 0; s < 4; ++s) { const bf16x8 ka = *(const LAS bf16x8*)(kb + r * 144 + 32 * s + 16 * hh);
                        x = __builtin_amdgcn_mfma_f32_32x32x16_bf16(ka, bq[s], x, 0, 0, 0); }
                    X[T] = x;
                }
                __builtin_amdgcn_sched_barrier(0);
            }
            u32x4 vf[5][4];
            const int va0 = qbase + dil * ((lane >> 3) - 128); const unsigned vcolb = (unsigned)((C_V + h * HD + (lane & 7) * 8) * 2);
#pragma unroll
            for (int T = 0; T < 3; ++T)
#pragma unroll
                for (int c = 0; c < 4; ++c) { const int kposn = va0 + (32 * T + 8 * c) * dil;
                    vf[T][c] = *(const u32x4*)(Vb + (size_t)((unsigned)(kposn < 0 ? 0 : kposn) * 128u + (unsigned)((lane & 7) * 16))); }
#pragma unroll
            for (int u = 0; u < 4; ++u) __builtin_nontemporal_store(cpv[u], (f32x4*)(cp_dst + (size_t)cpo[u]));
#pragma unroll
            for (int u = 0; u < 4; ++u) { cpo[u] = CP_OFF(256 + 64 * u); cpv[u] = __builtin_nontemporal_load((const f32x4*)(cp_src + (size_t)cpo[u])); }
            __builtin_amdgcn_sched_barrier(0);
            const int nneg = 128 - (qbase >> (2 * p));
            const int nlo = (r > nneg ? r : nneg) - 4 * hh, nhi = r + 128 - 4 * hh;
            const int tneg = (nneg > 0) ? ((nneg - 1) >> 5) : -1;
            float mraw = -INFINITY;
#pragma unroll
            for (int T = 0; T < 5; ++T) {
                if (T == 0 || T == 4 || T <= tneg) {
#pragma unroll
                    for (int i = 0; i < 16; ++i) {
                        const int nc = 32 * T + (i & 3) + 8 * (i >> 2);
                        const bool valid = (T == 4 ? nc <= nhi : true) && (T < 4 ? nc >= nlo : true);
                        const float v = valid ? X[T][i] : -INFINITY; X[T][i] = v; mraw = fmaxf(mraw, v);
                    }
                } else {
#pragma unroll
                    for (int i = 0; i < 16; ++i) mraw = fmaxf(mraw, X[T][i]);
                }
            }
            { auto rr = __builtin_amdgcn_permlane32_swap(__float_as_uint(mraw), __float_as_uint(mraw), false, false); mraw = fmaxf(__uint_as_float(rr[0]), __uint_as_float(rr[1])); }
            const float m = mraw * SC, negm = -m;
            float l = 0.f;
#pragma unroll
            for (int T = 0; T < 5; ++T)
#pragma unroll
                for (int i = 0; i < 16; ++i) { const float pe = __builtin_amdgcn_exp2f(__builtin_fmaf(X[T][i], SC, negm)); X[T][i] = pe; l += pe; }
            { auto rr = __builtin_amdgcn_permlane32_swap(__float_as_uint(l), __float_as_uint(l), false, false); l = __uint_as_float(rr[0]) + __uint_as_float(rr[1]); }
            __builtin_amdgcn_sched_barrier(0);
            f32x16 o0, o1;
#pragma unroll
            for (int i = 0; i < 16; ++i) { o0[i] = 0.f; o1[i] = 0.f; }
#pragma unroll
            for (int T = 0; T < 5; ++T) {
                if (T == 1) {
#pragma unroll
                    for (int T2 = 3; T2 < 5; ++T2)
#pragma unroll
                        for (int c = 0; c < 4; ++c) { const int kposn = va0 + (32 * T2 + 8 * c) * dil;
                            vf[T2][c] = *(const u32x4*)(Vb + (size_t)((unsigned)(kposn < 0 ? 0 : kposn) * 128u + (unsigned)((lane & 7) * 16))); }
                }
#pragma unroll
                for (int c = 0; c < 4; ++c) { const int chunk = lane + 64 * c, vr = chunk >> 3, vc = chunk & 7;
                    *(LAS u32x4*)(Vsh + vr * 144 + vc * 16) = vf[T][c]; }
                __builtin_amdgcn_sched_barrier(0);
#pragma unroll
                for (int s2 = 0; s2 < 2; ++s2) {
                    bf16x8 pb;
#pragma unroll
                    for (int j = 0; j < 8; j += 2) { const unsigned w = pk2(X[T][8 * s2 + j], X[T][8 * s2 + j + 1]); pb[j] = (short)(w & 0xffffu); pb[j + 1] = (short)(w >> 16); }
                    const s16x4 a0lo = vtr(vtb + (16 * s2) * 144),      a0hi = vtr(vtb + (16 * s2 + 8) * 144);
                    const s16x4 a1lo = vtr(vtb + (16 * s2) * 144 + 64), a1hi = vtr(vtb + (16 * s2 + 8) * 144 + 64);
                    const bf16x8 va0 = (bf16x8){a0lo[0], a0lo[1], a0lo[2], a0lo[3], a0hi[0], a0hi[1], a0hi[2], a0hi[3]};
                    const bf16x8 va1 = (bf16x8){a1lo[0], a1lo[1], a1lo[2], a1lo[3], a1hi[0], a1hi[1], a1hi[2], a1hi[3]};
                    o0 = __builtin_amdgcn_mfma_f32_32x32x16_bf16(va0, pb, o0, 0, 0, 0);
                    o1 = __builtin_amdgcn_mfma_f32_32x32x16_bf16(va1, pb, o1, 0, 0, 0);
                }
                __builtin_amdgcn_sched_barrier(0);
            }
#pragma unroll
            for (int u = 0; u < 4; ++u) __builtin_nontemporal_store(cpv[u], (f32x4*)(cp_dst + (size_t)cpo[u]));
#undef CP_OFF
            const float inv = 1.f / l; float L2 = m + __builtin_amdgcn_logf(l);
            const int ql = qpos - t0;
            float wo = 0.f, wn = inv;
            if (p > 0) { const float Lold = Lsh[ql]; const float mx = fmaxf(Lold, L2);
                const float Ln = mx + __builtin_amdgcn_logf(__builtin_amdgcn_exp2f(Lold - mx) + __builtin_amdgcn_exp2f(L2 - mx));
                wo = __builtin_amdgcn_exp2f(Lold - Ln); wn = __builtin_amdgcn_exp2f(L2 - Ln) * inv; L2 = Ln; }
#pragma unroll
            for (int dh = 0; dh < 2; ++dh)
#pragma unroll
                for (int g4 = 0; g4 < 4; ++g4) {
                    LAS u32x2* op = (LAS u32x2*)(Osh + ql * OSH_STRIDE + (32 * dh + 8 * g4 + 4 * hh) * 2);
                    float v0, v1, v2, v3;
                    if (dh == 0) { v0 = o0[4 * g4] * wn; v1 = o0[4 * g4 + 1] * wn; v2 = o0[4 * g4 + 2] * wn; v3 = o0[4 * g4 + 3] * wn; }
                    else         { v0 = o1[4 * g4] * wn; v1 = o1[4 * g4 + 1] * wn; v2 = o1[4 * g4 + 2] * wn; v3 = o1[4 * g4 + 3] * wn; }
                    if (p > 0) { const u32x2 old = *op; v0 += bflo(old.x) * wo; v1 += bfhi(old.x) * wo; v2 += bflo(old.y) * wo; v3 += bfhi(old.y) * wo; }
                    u32x2 nw; nw.x = pk2(v0, v1); nw.y = pk2(v2, v3); *op = nw;
                }
            if (hh == 0) Lsh[ql] = L2;
        }
        __syncthreads();
    }
    const int tid = otid(wid);
#pragma unroll
    for (int it = 0; it < 8; ++it) { const int chunk = tid + 512 * it, row = chunk >> 3, c = chunk & 7;
        const u32x4 ov = *(const LAS u32x4*)(Osh + row * OSH_STRIDE + c * 16);
        const size_t grow = rowbase + t0 + row;
        const u32x4 gv = *(const u32x4*)(Z + grow * INW + C_GA + h * HD + c * 8);
        u32x4 w;
        w.x = pk2(bflo(ov.x) * silu(bflo(gv.x)), bfhi(ov.x) * silu(bfhi(gv.x)));
        w.y = pk2(bflo(ov.y) * silu(bflo(gv.y)), bfhi(ov.y) * silu(bfhi(gv.y)));
        w.z = pk2(bflo(ov.z) * silu(bflo(gv.z)), bfhi(ov.z) * silu(bfhi(gv.z)));
        w.w = pk2(bflo(ov.w) * silu(bflo(gv.w)), bfhi(ov.w) * silu(bfhi(gv.w)));
        *(u32x4*)(MIX + grow * DM + h * HD + c * 8) = w; }
    __syncthreads();
}

template <int W>
__device__ __forceinline__ void pooled_item(const bf16_t* up, bf16_t* pp, int row0, int pos0) {
    u32x4 R[W + 7];
#pragma unroll
    for (int k = 0; k < W + 7; ++k) { const int d = k - (W - 1);
        R[k] = (pos0 + d >= 0) ? *(const u32x4*)(up + (size_t)(row0 + d) * INW) : (u32x4){0u, 0u, 0u, 0u}; }
    float S[8];
#pragma unroll
    for (int c = 0; c < 8; ++c) S[c] = 0.f;
#pragma unroll
    for (int k = 0; k < W - 1; ++k) { S[0] += bflo(R[k].x); S[1] += bfhi(R[k].x); S[2] += bflo(R[k].y); S[3] += bfhi(R[k].y); S[4] += bflo(R[k].z); S[5] += bfhi(R[k].z); S[6] += bflo(R[k].w); S[7] += bfhi(R[k].w); }
#pragma unroll
    for (int j = 0; j < 8; ++j) {
        const u32x4 v = R[W - 1 + j], q = R[j];
        const float c[8] = {bflo(v.x), bfhi(v.x), bflo(v.y), bfhi(v.y), bflo(v.z), bfhi(v.z), bflo(v.w), bfhi(v.w)};
        const int pos = pos0 + j; const float icnt = 1.f / (float)((pos + 1 < W) ? pos + 1 : W);
        float o[8];
#pragma unroll
        for (int k = 0; k < 8; ++k) { S[k] += c[k]; o[k] = S[k] * icnt - c[k]; }
        u32x4 ov; ov.x = pk2(o[0], o[1]); ov.y = pk2(o[2], o[3]); ov.z = pk2(o[4], o[5]); ov.w = pk2(o[6], o[7]);
        *(u32x4*)(pp + (size_t)(row0 + j) * 256) = ov;
        S[0] -= bflo(q.x); S[1] -= bfhi(q.x); S[2] -= bflo(q.y); S[3] -= bfhi(q.y); S[4] -= bflo(q.z); S[5] -= bfhi(q.z); S[6] -= bflo(q.w); S[7] -= bfhi(q.w);
    }
}

template <int CH>
__device__ __forceinline__ void pool_tile16(LAS unsigned char* lds, const bf16x8 (&tf)[8]  , const bf16_t* zrow  , bf16_t* orow  ,
                                            const float* pool_scale, int g, int fr, int fq, int nt0, int nchunks) {
    u32x2 gvv[CH], gvn[CH]; f32x4 scv[CH], scn[CH];
#pragma unroll
    for (int k = 0; k < CH; ++k) { const int c = g * 256 + (nt0 + k) * 16 + 4 * fq; gvv[k] = *(const u32x2*)(zrow + C_GP + c); scv[k] = *(const f32x4*)(pool_scale + c); }
#pragma unroll 1
    for (int ch = 0; ch < nchunks; ++ch) {
        const int chn = (ch + 1 < nchunks) ? ch + 1 : ch;
#pragma unroll
        for (int k = 0; k < CH; ++k) { const int c = g * 256 + (nt0 + CH * chn + k) * 16 + 4 * fq; gvn[k] = *(const u32x2*)(zrow + C_GP + c); scn[k] = *(const f32x4*)(pool_scale + c); }
#pragma unroll
        for (int k = 0; k < CH; ++k) {
            const int nt = nt0 + CH * ch + k;
            f32x4 acc = (f32x4){0.f, 0.f, 0.f, 0.f};
#pragma unroll
            for (int s = 0; s < 8; ++s) { const bf16x8 wf = *(const LAS bf16x8*)(lds + (nt * 16 + fr) * 528 + (32 * s + 8 * fq) * 2);
                acc = __builtin_amdgcn_mfma_f32_16x16x32_bf16(wf, tf[s], acc, 0, 0, 0); }
            const int c = g * 256 + nt * 16 + 4 * fq;
            const f32x4 sc = scv[k]; const u32x2 gv = gvv[k];
            u32x2 w; w.x = pk2(acc[0] * sc.x * silu(bflo(gv.x)), acc[1] * sc.y * silu(bfhi(gv.x))); w.y = pk2(acc[2] * sc.z * silu(bflo(gv.y)), acc[3] * sc.w * silu(bfhi(gv.y)));
            *(u32x2*)(orow + AW + c) = w;
        }
#pragma unroll
        for (int k = 0; k < CH; ++k) { gvv[k] = gvn[k]; scv[k] = scn[k]; }
    }
}
__device__ __forceinline__ void pool_stage_load(u32x4 (&wv)[16], const bf16_t* WPOOL, int g, int tid) {
    const bf16_t* Wg = WPOOL + (size_t)g * 65536;
#pragma unroll
    for (int k = 0; k < 16; ++k) { const int i = tid + 512 * k; wv[k] = *(const u32x4*)(Wg + (i >> 5) * 256 + (i & 31) * 8); }
}
__device__ __forceinline__ void pool_stage_store(LAS unsigned char* lds, const u32x4 (&wv)[16], int tid) {
#pragma unroll
    for (int k = 0; k < 16; ++k) { const int i = tid + 512 * k; *(LAS u32x4*)(lds + (i >> 5) * 528 + (i & 31) * 16) = wv[k]; }
}
__device__ __forceinline__ void pool_stage(LAS unsigned char* lds, const bf16_t* WPOOL, int g, int tid) { u32x4 wv[16]; pool_stage_load(wv, WPOOL, g, tid); pool_stage_store(lds, wv, tid); }
__device__ __forceinline__ void pool_unit(LAS unsigned char* lds, const bf16_t* POOLED, const bf16_t* POOLEDS, const bf16_t* WPOOL, const bf16_t* Z, bf16_t* MIX, const float* pool_scale, int g, int rb, int tid, bool staged) {
    const int lane = tid & 63, wave = tid >> 6, fr = lane & 15, fq = lane >> 4;
    const int row = rb * 128 + wave * 16 + fr;
    bf16x8 tf[8];
    { const bf16_t* arow = POOLED + ((size_t)g * MP + row) * 256 + fq * 8;
#pragma unroll
      for (int s = 0; s < 8; ++s) tf[s] = *(const bf16x8*)(arow + 32 * s); }
    if (!staged) pool_stage(lds, WPOOL, g, tid);
    __syncthreads();
    pool_tile16<4>(lds, tf, Z + (size_t)row * INW, MIX + (size_t)row * DM, pool_scale, g, fr, fq, 0, 4);
    if (rb == 0) {
#pragma unroll 1
        for (int hf = 0; hf < 2; ++hf) { const int srow = hf * 16 + fr; bf16x8 ts[8];
            { const bf16_t* arow = POOLEDS + ((size_t)g * MS + srow) * 256 + fq * 8;
#pragma unroll
              for (int s = 0; s < 8; ++s) ts[s] = *(const bf16x8*)(arow + 32 * s); }
            pool_tile16<2>(lds, ts, Z + (size_t)(MP + srow) * INW, MIX + (size_t)(MP + srow) * DM, pool_scale, g, fr, fq, 2 * wave, 1); }
    }
    __syncthreads();
}

__device__ __forceinline__ void attn_sample_round(LAS unsigned char* lds, const Args& a, const bf16_t* Z, bf16_t* MIX, int task, int tid) {
    const int lane = tid & 63, wave = tid >> 6, q4 = wave & 3, half = wave >> 2;
    LAS float* msh = (LAS float*)(lds + 8192);
    const bool act = task < DB * DT * NH;
    const int h = task & 15, t = (task >> 4) & 3, b = (task >> 6) & 7;
    const size_t zrow = (size_t)(MP + b * DT + t) * INW;
    if (act) {
        const float* ks = a.out + O_KS; const float* vs = a.out + O_VS;
        const int slot = lane >> 4, c4 = lane & 15, e0 = 97 * q4;
        float qv[4];
        { const u32x2 w = *(const u32x2*)(Z + zrow + C_Q + h * HD + 4 * c4); qv[0] = bflo(w.x); qv[1] = bfhi(w.x); qv[2] = bflo(w.y); qv[3] = bfhi(w.y); }
        float sc[25]; float m = -INFINITY;
#pragma unroll
        for (int i = 0; i < 25; ++i) {
            const int el = slot + 4 * i, e = e0 + el; const bool valid = (el < 97) && (e < 387); const int ec = valid ? e : 0;
            const int p = (ec >= 129) + (ec >= 258), j = ec - 129 * p, R = BUF + t - (j << (2 * p));
            const float* kr = (R < BUF) ? a.cache_k + ((size_t)(b * BUF + R) * NH + h) * HD : ks + ((size_t)(b * BUF + R - DT) * NH + h) * HD;
            const f32x4 kv = *(const f32x4*)(kr + 4 * c4);
            float s = (qv[0] * kv.x + qv[1] * kv.y) + (qv[2] * kv.z + qv[3] * kv.w);
            s += __shfl_xor(s, 1); s += __shfl_xor(s, 2); s += __shfl_xor(s, 4); s += __shfl_xor(s, 8);
            s = valid ? s * 0.125f * LOG2E : -INFINITY; sc[i] = s; m = fmaxf(m, s);
        }
        m = fmaxf(m, __shfl_xor(m, 16)); m = fmaxf(m, __shfl_xor(m, 32));
        float l = 0.f;
#pragma unroll
        for (int i = 0; i < 25; ++i) { const float pe = __builtin_amdgcn_exp2f(sc[i] - m); sc[i] = pe; l += pe; }
        l += __shfl_xor(l, 16); l += __shfl_xor(l, 32);
        f32x4 acc = (f32x4){0.f, 0.f, 0.f, 0.f};
#pragma unroll
        for (int i = 0; i < 25; ++i) {
            const int el = slot + 4 * i, e = e0 + el; const bool valid = (el < 97) && (e < 387); const int ec = valid ? e : 0;
            const float pe = sc[i];
            const int p = (ec >= 129) + (ec >= 258), j = ec - 129 * p, R = BUF + t - (j << (2 * p));
            const float* vr = (R < BUF) ? a.cache_v + ((size_t)(b * BUF + R) * NH + h) * HD : vs + ((size_t)(b * BUF + R - DT) * NH + h) * HD;
            const f32x4 vv = *(const f32x4*)(vr + 4 * c4);
            acc.x += pe * vv.x; acc.y += pe * vv.y; acc.z += pe * vv.z; acc.w += pe * vv.w;
        }
        acc.x += __shfl_xor(acc.x, 16); acc.y += __shfl_xor(acc.y, 16); acc.z += __shfl_xor(acc.z, 16); acc.w += __shfl_xor(acc.w, 16);
        acc.x += __shfl_xor(acc.x, 32); acc.y += __shfl_xor(acc.y, 32); acc.z += __shfl_xor(acc.z, 32); acc.w += __shfl_xor(acc.w, 32);
        if (lane < 16) { LAS float* d = msh + wave * 68 + 4 * c4; d[0] = acc.x; d[1] = acc.y; d[2] = acc.z; d[3] = acc.w; }
        if (lane == 0) { msh[wave * 68 + 64] = m; msh[wave * 68 + 65] = l; }
    }
    __syncthreads();
    if (act && q4 == 0 && lane < 16) {
        const LAS float* s0 = msh + (half * 4) * 68;
        const float m0 = s0[64], m1 = s0[68 + 64], m2 = s0[136 + 64], m3 = s0[204 + 64];
        const float M = fmaxf(fmaxf(m0, m1), fmaxf(m2, m3));
        const float w0 = __builtin_amdgcn_exp2f(m0 - M), w1 = __builtin_amdgcn_exp2f(m1 - M), w2 = __builtin_amdgcn_exp2f(m2 - M), w3 = __builtin_amdgcn_exp2f(m3 - M);
        const float L = s0[65] * w0 + s0[68 + 65] * w1 + s0[136 + 65] * w2 + s0[204 + 65] * w3;
        const float inv = 1.f / L;
        float o[4];
#pragma unroll
        for (int k = 0; k < 4; ++k) o[k] = (s0[4 * lane + k] * w0 + s0[68 + 4 * lane + k] * w1 + s0[136 + 4 * lane + k] * w2 + s0[204 + 4 * lane + k] * w3) * inv;
        const u32x2 gv = *(const u32x2*)(Z + zrow + C_GA + h * HD + 4 * lane);
        u32x2 w; w.x = pk2(o[0] * silu(bflo(gv.x)), o[1] * silu(bfhi(gv.x))); w.y = pk2(o[2] * silu(bflo(gv.y)), o[3] * silu(bfhi(gv.y)));
        *(u32x2*)(MIX + (size_t)(MP + b * DT + t) * DM + h * HD + 4 * lane) = w;
    }
    __syncthreads();
}

__global__ void __launch_bounds__(512, 2) hymba_fwd(Args a) {
    extern __shared__ __attribute__((aligned(16))) unsigned char lds_raw[];
    LAS unsigned char* lds = (LAS unsigned char*)lds_raw;
    cg::grid_group grid = cg::this_grid();
    if (a.ws == nullptr) grid.sync();
    if (threadIdx.x < 4) ((volatile LAS unsigned*)(lds + LDS_BYTES - 64))[threadIdx.x] = 0u;
    __syncthreads();
    const XcdBarrier xbar = xcd_barrier_post((unsigned*)(a.ws + WS_BAR), (volatile LAS unsigned*)(lds + LDS_BYTES - 64));
    const int G = gridDim.x, bx = blockIdx.x;
    const int wave0 = __builtin_amdgcn_readfirstlane(threadIdx.x >> 6);
    const int vcu = osgpr((G % 8 == 0) ? (bx % 8) * (G / 8) + bx / 8 : bx);
#define PHASE_IDS const int tid = otid(wave0), lane = tid & 63, wave = wave0; \
    const int gw = osgpr(vcu * 8 + wave), NGW = G * 8, gt = osgpr(vcu * 512) + tid, NGT = G * 512; (void)gw; (void)NGW; (void)gt; (void)NGT; (void)lane;
    unsigned char* ws = a.ws;
    bf16_t* WIN = (bf16_t*)(ws + WS_WIN); bf16_t* WOUT = (bf16_t*)(ws + WS_WOUT); bf16_t* WPOOL = (bf16_t*)(ws + WS_WPOOL);
    bf16_t* XN = (bf16_t*)(ws + WS_XN); bf16_t* Z = (bf16_t*)(ws + WS_Z); bf16_t* MIX = (bf16_t*)(ws + WS_MIX);
    bf16_t* POOLED = (bf16_t*)(ws + WS_POOLED); bf16_t* POOLEDS = (bf16_t*)(ws + WS_POOLEDS);

#if PHM & 1
    for (int rep_ = 0; rep_ < 1 + ((PHDUP >> 0) & 1); ++rep_) {
        PHASE_IDS
        LAS float* scr = (LAS float*)(lds + wave * 16384);
        constexpr int I_IN = (DM / 64) * (INW / 32), I_OUT = (DM / 64) * (DM / 32), I_PL = (256 / 64) * (256 / 32);
        constexpr int NITEMS = I_IN + 4 * I_PL;
        for (int it = gw; it < NITEMS; it += NGW) {
            int r = it;
            if (r < I_IN) { p0_transpose_item(a.w_in, DM, INW, WIN, scr, r, lane); continue; } r -= I_IN;
            const int g = r / I_PL; r -= g * I_PL;
            p0_transpose_item(a.w_pool + (size_t)g * 65536, 256, 256, WPOOL + (size_t)g * 65536, scr, r, lane);
        }
        for (int m = gw; m < MT; m += NGW) {
            const float* xr = (m < MP) ? a.x_prompt + (size_t)m * DM : a.x_sample + (size_t)(m - MP) * DM;
            rms_row_to_bf16(xr, a.norm_g, XN + (size_t)m * DM, lane);
        }
        {
            for (int i0 = CP_ATT + gt; i0 < 2 * CP_N; i0 += 8 * NGT) {
                f32x4 cv[8]; f32x4* cd[8];
#pragma unroll
                for (int u = 0; u < 8; ++u) { const int i = i0 + u * NGT; const f32x4* sp; cp_addr(a, i < 2 * CP_N ? i : CP_ATT, sp, cd[u]); cv[u] = __builtin_nontemporal_load(sp); }
#pragma unroll
                for (int u = 0; u < 8; ++u) if (i0 + u * NGT < 2 * CP_N) __builtin_nontemporal_store(cv[u], cd[u]);
            }
            constexpr int PPER_B = (PH - DT) * PW / 4, NPP = DB * PPER_B;
            f32x4* pd = (f32x4*)(a.out + O_PS); const f32x4* psrc = (const f32x4*)a.state_pool;
            for (int i = gt; i < NPP; i += NGT) { const int b = i / PPER_B, o = i - b * PPER_B;
                pd[(size_t)b * (PH * PW / 4) + o] = psrc[(size_t)b * (PH * PW / 4) + DT * PW / 4 + o]; }
        }
    }
#endif
    GRID_SYNC();

#if PHM & 2
    for (int rep_ = 0; rep_ < 1 + ((PHDUP >> 1) & 1); ++rep_) {
        SEpiZ se{Z, a.out};
        small_gemm(lds, XN + (size_t)MP * DM, WIN, INW / 32, DM, bx, G, se, otid(wave0));
        pg8::Gemm g{XN, WIN, MP, INW, DM}; pg8::StaticOrder S; S.init(MP, INW, G, bx);
        EpiZ E{Z, a.out, (bf16_t*)(ws + WS_KC), (bf16_t*)(ws + WS_VC)};
        pg8::gemm_phase<EpiZ, pg8::StaticOrder, true, true>(lds, g, S, E, otid(wave0));
    }
#endif
    GRID_SYNC();

#if PHM & 4
    for (int rep_ = 0; rep_ < 1 + ((PHDUP >> 2) & 1); ++rep_) {
        PHASE_IDS
        for (int u = vcu; u < NB * NH * 8; u += G) attn_prompt_unit(lds, Z, MIX, u >> 7, (u >> 3) & 15, u & 7, wave0, a, u, (const bf16_t*)(ws + WS_KC), (const bf16_t*)(ws + WS_VC));
        u32x4 wpf[16]; pool_stage_load(wpf, WPOOL, (vcu < 256 ? vcu : 0) >> 6, tid);
        {
            LAS float* scr = (LAS float*)(lds + wave * 16384);
            constexpr int I_OUT2 = (DM / 64) * (DM / 32);
            for (int it = gw; it < I_OUT2; it += NGW) p0_transpose_item(a.w_out, DM, DM, WOUT, scr, it, lane);
            __syncthreads();
        }
        for (int item = gt; item < 4 * (MP / 8) * 32; item += NGT) {
            const int cc = item & 31, rc = (item >> 5) & (MP / 8 - 1), g = item >> 15, row0 = rc * 8, pos0 = row0 & (SEQ - 1);
            const bf16_t* up = Z + C_U + g * 256 + cc * 8; bf16_t* pp = POOLED + ((size_t)g * MP) * 256 + cc * 8;
            if (g == 0) pooled_item<2>(up, pp, row0, pos0); else if (g == 1) pooled_item<4>(up, pp, row0, pos0);
            else if (g == 2) pooled_item<8>(up, pp, row0, pos0); else pooled_item<16>(up, pp, row0, pos0);
        }
        for (int i = gt; i < MS * PW; i += NGT) {
            const int c = i & (PW - 1), rw = i >> 10, b = rw >> 2, t = rw & 3, g = c >> 8, w = 2 << g;
            float s = 0.f, cur = 0.f;
#pragma unroll
            for (int k = 0; k < 16; ++k) if (k < w) { const int e = PH + t - k;
                const float v = (e < PH) ? a.state_pool[((size_t)b * PH + e) * PW + c] : __builtin_bit_cast(float, (unsigned)Z[(size_t)(MP + b * DT + e - PH) * INW + C_U + c] << 16);
                s += v; if (k == 0) cur = v; }
            POOLEDS[((size_t)g * MS + rw) * 256 + (c & 255)] = (bf16_t)f2bf(s / (float)w - cur);
        }
        __syncthreads(); pool_stage_store(lds, wpf, tid);
    }
#endif
    GRID_SYNC();

#if PHM & 8
    for (int rep_ = 0; rep_ < 1 + ((PHDUP >> 3) & 1); ++rep_) {
        PHASE_IDS
        for (int u = vcu; u < 256; u += G) pool_unit(lds, POOLED, POOLEDS, WPOOL, Z, MIX, a.pool_scale, u >> 6, u & 63, tid, (u == vcu) && (PHDUP == 0));
        for (int pi = vcu; pi < DB * DT * NH / 2; pi += G) attn_sample_round(lds, a, Z, MIX, 2 * pi + (wave >> 2), tid);
    }
#endif
    GRID_SYNC();

#if PHM & 16
    for (int rep_ = 0; rep_ < 1 + ((PHDUP >> 4) & 1); ++rep_) {
        if (bx < DM / 32) sample_out_unit(lds, MIX + (size_t)MP * DM, WOUT, a.x_sample, a.out + O_YS, a.final_g, (float*)(ws + WS_SLOTS) + (size_t)MP * 8, (unsigned*)(ws + WS_CNT) + 64 * 32, bx, otid(wave0));
        pg8::Gemm g{MIX, WOUT, MP, DM, DM}; pg8::StaticOrder S; S.init(MP, DM, G, bx);
        EpiYN E{a.x_prompt, a.out + O_YP, a.final_g, (float*)(ws + WS_SLOTS), (unsigned*)(ws + WS_CNT)};
        pg8::gemm_phase<EpiYN, pg8::StaticOrder, false, true>(lds, g, S, E, otid(wave0));
    }
#endif
}

extern "C" void kernel_launch(void* const* d_in, const int* in_sizes, int n_in, void* d_out, int out_size, void* d_ws, size_t ws_size, hipStream_t stream) {
    static int grid = 0;
    if (grid == 0) {
        int dev = 0, cus = 0, per_cu = 0;
        hipGetDevice(&dev);
        hipDeviceGetAttribute(&cus, hipDeviceAttributeMultiprocessorCount, dev);
        if (hipFuncSetAttribute((const void*)hymba_fwd, hipFuncAttributeMaxDynamicSharedMemorySize, LDS_BYTES) != hipSuccess) { fprintf(stderr, "hipFuncSetAttribute failed\n"); grid = -1; return; }
        if (hipOccupancyMaxActiveBlocksPerMultiprocessor(&per_cu, (const void*)hymba_fwd, 512, LDS_BYTES) != hipSuccess || per_cu < 1) { fprintf(stderr, "occupancy query: %d\n", per_cu); per_cu = 1; }
        (void)hipGetLastError();
        grid = cus;
    }
    if (grid < 0) return;
    if (hipMemsetAsync(d_ws, 0, CTL_ZERO_BYTES, stream) != hipSuccess) { fprintf(stderr, "memset failed\n"); return; }
    Args a{};
    a.x_prompt = (const float*)d_in[0]; a.x_sample = (const float*)d_in[1]; a.cache_k = (const float*)d_in[2]; a.cache_v = (const float*)d_in[3];
    a.state_pool = (const float*)d_in[4]; a.norm_g = (const float*)d_in[5]; a.w_in = (const float*)d_in[6]; a.w_pool = (const float*)d_in[7];
    a.pool_scale = (const float*)d_in[8]; a.w_out = (const float*)d_in[9]; a.final_g = (const float*)d_in[10];
    a.out = (float*)d_out; a.ws = (unsigned char*)d_ws;
    void* args[] = {&a};
    hipError_t e = hipLaunchCooperativeKernel((const void*)hymba_fwd, dim3(grid), dim3(512), args, LDS_BYTES, stream);
    if (e != hipSuccess) fprintf(stderr, "cooperative launch failed: %s (grid %d)\n", hipGetErrorString(e), grid);
}
```

```cpp
#include <hip/hip_runtime.h>
#include <hip/hip_cooperative_groups.h>
#include <cstdio>
#include <cstdint>
namespace cg = cooperative_groups;
#define LAS __attribute__((address_space(3)))
namespace pg8 {
#define PG8_LAS __attribute__((address_space(3)))
typedef unsigned short bf16_t;
typedef short bf16x8 __attribute__((ext_vector_type(8)));
typedef float f32x4 __attribute__((ext_vector_type(4)));
typedef unsigned u32x4 __attribute__((ext_vector_type(4)));
constexpr int BM = 256, BK = 64, HALF = 128, HTB = HALF * BK * 2  , STAGE_BYTES = 8 * HTB, NXCD = 8, WGM = 8;

__host__ __device__ __forceinline__ int lds_byte(int r, int c) { const int st = (r >> 4) * 2 + (c >> 5), rr = r & 15, cc = c & 31, ob = rr * 64 + cc * 2; return st * 1024 + (ob ^ (((ob >> 9) & 1) << 5)); }
__host__ __device__ __forceinline__ void stage_rc(int b, int& R, int& C) { const int st = b / 1024, sb = b % 1024, swz = sb ^ (((sb >> 9) & 1) << 5); R = (st >> 1) * 16 + swz / 64; C = (st & 1) * 32 + (swz % 64) / 2; }
__host__ __device__ __forceinline__ int perm32(int rho) { const int n = rho >> 4, i = rho & 15; return 8 * (i >> 2) + 4 * n + (i & 3); }

struct Unit { int pm, pn; };
struct Gemm { const bf16_t* A; const bf16_t* Bt; int M, N, K; };

struct StaticOrder {
    int nM, nN, nwg, G, c;
    __host__ __device__ void init(int M, int N, int G_, int c_) { nM = M / BM; nN = N / BM; nwg = nM * nN; G = G_; c = c_; }
    __host__ __device__ bool next(int i, Unit& u) const {
        const long L = (long)i * G + c; if (L >= nwg) return false;
        int wgid = (int)L; { const int q = nwg / NXCD, r = nwg % NXCD, xcd = wgid % NXCD, off = wgid / NXCD; wgid = (xcd < r ? xcd * (q + 1) : r * (q + 1) + (xcd - r) * q) + off; }
        const int nig = WGM * nN, gid = wgid / nig, fm = gid * WGM, gsz = (nM - fm) < WGM ? (nM - fm) : WGM;
        u.pm = fm + ((wgid % nig) % gsz); u.pn = (wgid % nig) / gsz; return true;
    }
    __device__ __forceinline__ void a_ready(const Unit&) const {}
    __device__ __forceinline__ void done(const Unit&) const {}
};

__device__ __forceinline__ unsigned cvt_pk_bf16(float lo, float hi) { unsigned r; asm volatile("v_cvt_pk_bf16_f32 %0, %1, %2" : "=v"(r) : "v"(lo), "v"(hi)); return r; }
template <class Epi, class Sched, bool ALIGN_EPI = false, bool SP2 = false>
__device__ __forceinline__ void gemm_phase(PG8_LAS unsigned char* lds, const Gemm g, const Sched& S, const Epi& E, const int tid_in) {
    int tid_ = tid_in; asm volatile("" : "+v"(tid_));
    const int tid = tid_, wid = __builtin_amdgcn_readfirstlane(tid >> 6), lane = tid & 63, wr = wid >> 2, wc = wid & 3, fr = lane & 15, fq = lane >> 4;
    const int K = g.K, nt = K / BK;
    unsigned voffA[2], voffB[2];
#pragma unroll
    for (int i = 0; i < 2; ++i) { int R, C; stage_rc(tid * 16 + i * 8192, R, C); const int Rb = Epi::PERM ? ((R & ~31) + perm32(R & 31)) : R;
        voffA[i] = (unsigned)(R * K + C) * 2u; voffB[i] = (unsigned)(Rb * K + C) * 2u; }
    const size_t kstep = (size_t)(BK * 2);
    const size_t hstep = (size_t)HALF * K * 2;
    const size_t tstep = 2 * hstep;
    const unsigned ldsw = (unsigned)wid * 1024u;
    const int aoff = lds_byte(wr * 64 + fr, fq * 8), boff = lds_byte(wc * 32 + fr, fq * 8);
#define PG8_SA(b, h) (((b) * 2 + (h)) * HTB)
#define PG8_SB(b, h) ((4 + (b) * 2 + (h)) * HTB)
#define PG8_STAGE(bufoff, gbase, voff) do { _Pragma("unroll") for (int _i = 0; _i < 2; ++_i) \
        __builtin_amdgcn_global_load_lds((const unsigned*)((const char*)(gbase) + (voff)[_i]), (PG8_LAS unsigned*)(lds + (bufoff) + ldsw + _i * 8192), 16, 0, 0); } while (0)
#define PG8_LDA(dst, b, h) do { _Pragma("unroll") for (int m = 0; m < 4; ++m) _Pragma("unroll") for (int k = 0; k < 2; ++k) dst[m][k] = *(const PG8_LAS bf16x8*)(lds + PG8_SA(b, h) + aoff + m * 2048 + k * 1024); } while (0)
#define PG8_LDB(dst, b, h) do { _Pragma("unroll") for (int n = 0; n < 2; ++n) _Pragma("unroll") for (int k = 0; k < 2; ++k) dst[n][k] = *(const PG8_LAS bf16x8*)(lds + PG8_SB(b, h) + boff + n * 2048 + k * 1024); } while (0)
#define PG8_MMA(ai, bj, At, Bt) do { __builtin_amdgcn_s_setprio(1); _Pragma("unroll") for (int m = 0; m < 4; ++m) _Pragma("unroll") for (int n = 0; n < 2; ++n) _Pragma("unroll") for (int k = 0; k < 2; ++k) \
        acc[ai][bj][m][n] = __builtin_amdgcn_mfma_f32_16x16x32_bf16(Bt[n][k], At[m][k], acc[ai][bj][m][n], 0, 0, 0); __builtin_amdgcn_s_setprio(0); } while (0)
#define PG8_WAIT_V(n) asm volatile("s_waitcnt vmcnt(" #n ")" ::: "memory")
#define PG8_WAIT_L(n) asm volatile("s_waitcnt lgkmcnt(" #n ")" ::: "memory")
#define PG8_BAR __builtin_amdgcn_s_barrier()
#define PG8_SCHED __builtin_amdgcn_sched_barrier(0)
    Unit cur, nxt; int ui = 0;
    if (!S.next(0, cur)) return;
    f32x4 acc[2][2][4][2];
#pragma unroll
    for (int a = 0; a < 2; ++a)
#pragma unroll
        for (int b = 0; b < 2; ++b)
#pragma unroll
            for (int m = 0; m < 4; ++m)
#pragma unroll
                for (int n = 0; n < 2; ++n) acc[a][b][m][n] = (f32x4){0.f, 0.f, 0.f, 0.f};
    bf16x8 At[4][2], B0[2][2], B1[2][2];
    const char* cA = (const char*)g.A + (size_t)cur.pm * tstep; const char* cB = (const char*)g.Bt + (size_t)cur.pn * tstep;
    S.a_ready(cur);
    if constexpr (SP2) {
        PG8_STAGE(PG8_SB(0, 0), cB, voffB); PG8_STAGE(PG8_SB(0, 1), cB + hstep, voffB); PG8_STAGE(PG8_SA(0, 0), cA, voffA); PG8_STAGE(PG8_SA(0, 1), cA + hstep, voffA);
        if (wr == 1) PG8_BAR;
        PG8_WAIT_V(2); PG8_BAR;
        PG8_STAGE(PG8_SB(1, 0), cB + kstep, voffB); PG8_STAGE(PG8_SA(1, 0), cA + kstep, voffA); PG8_STAGE(PG8_SB(1, 1), cB + hstep + kstep, voffB);
        PG8_WAIT_V(6); PG8_BAR;
    } else {
        PG8_STAGE(PG8_SB(0, 0), cB, voffB); PG8_STAGE(PG8_SA(0, 0), cA, voffA); PG8_STAGE(PG8_SB(0, 1), cB + hstep, voffB); PG8_STAGE(PG8_SA(0, 1), cA + hstep, voffA);
        if (wr == 1) PG8_BAR;
        PG8_WAIT_V(4); PG8_BAR;
        PG8_STAGE(PG8_SB(1, 0), cB + kstep, voffB); PG8_STAGE(PG8_SA(1, 0), cA + kstep, voffA); PG8_STAGE(PG8_SB(1, 1), cB + hstep + kstep, voffB);
        PG8_WAIT_V(6); PG8_BAR;
    }
    for (;;) {
        const bool has_next = S.next(ui + 1, nxt);
        const char* nA = has_next ? (const char*)g.A + (size_t)nxt.pm * tstep : cA; const char* nB = has_next ? (const char*)g.Bt + (size_t)nxt.pn * tstep : cB;
        for (int t = 0; t < nt; t += 2) {
            const bool last = (t == nt - 2);
            const char* a1 = cA + (size_t)(t + 1) * kstep;
            const char* a2 = last ? nA : cA + (size_t)(t + 2) * kstep; const char* b2 = last ? nB : cB + (size_t)(t + 2) * kstep;
            const char* a3 = a2 + kstep; const char* b3 = b2 + kstep;
            if (last && has_next) S.a_ready(nxt);
            if constexpr (SP2) {
            PG8_LDB(B0, 0, 0); PG8_LDB(B1, 0, 1); PG8_SCHED; PG8_LDA(At, 0, 0); PG8_STAGE(PG8_SA(1, 1), a1 + hstep, voffA);
            PG8_WAIT_V(8); PG8_WAIT_L(0); PG8_BAR; PG8_MMA(0, 0, At, B0); PG8_MMA(0, 1, At, B1); PG8_BAR; PG8_SCHED;
            PG8_LDA(At, 0, 1); PG8_STAGE(PG8_SB(0, 0), b2, voffB); PG8_STAGE(PG8_SB(0, 1), b2 + hstep, voffB); PG8_STAGE(PG8_SA(0, 0), a2, voffA);
            PG8_WAIT_V(8); PG8_WAIT_L(0); PG8_BAR; PG8_MMA(1, 0, At, B0); PG8_MMA(1, 1, At, B1); PG8_BAR; PG8_SCHED;
            PG8_LDB(B0, 1, 0); PG8_LDB(B1, 1, 1); PG8_SCHED; PG8_LDA(At, 1, 0); PG8_STAGE(PG8_SA(0, 1), a2 + hstep, voffA);
            PG8_WAIT_V(8); PG8_WAIT_L(0); PG8_BAR; PG8_MMA(0, 0, At, B0); PG8_MMA(0, 1, At, B1); PG8_BAR; PG8_SCHED;
            PG8_LDA(At, 1, 1); PG8_STAGE(PG8_SB(1, 0), b3, voffB); PG8_STAGE(PG8_SB(1, 1), b3 + hstep, voffB); PG8_STAGE(PG8_SA(1, 0), a3, voffA);
            PG8_WAIT_V(8); PG8_WAIT_L(0); PG8_BAR; PG8_MMA(1, 0, At, B0); PG8_MMA(1, 1, At, B1); PG8_BAR; PG8_SCHED;
            } else {
            PG8_LDB(B0, 0, 0); PG8_SCHED; PG8_LDA(At, 0, 0); PG8_STAGE(PG8_SA(1, 1), a1 + hstep, voffA);
            PG8_WAIT_L(8); PG8_BAR; PG8_WAIT_L(0); PG8_MMA(0, 0, At, B0); PG8_BAR; PG8_SCHED;
            PG8_LDB(B1, 0, 1); PG8_STAGE(PG8_SB(0, 0), b2, voffB);
            PG8_BAR; PG8_WAIT_L(0); PG8_MMA(0, 1, At, B1); PG8_BAR;
            PG8_LDA(At, 0, 1); PG8_STAGE(PG8_SA(0, 0), a2, voffA);
            PG8_BAR; PG8_WAIT_L(0); PG8_MMA(1, 0, At, B0); PG8_BAR; PG8_SCHED;
            PG8_STAGE(PG8_SB(0, 1), b2 + hstep, voffB);
            PG8_WAIT_V(6); PG8_BAR; PG8_MMA(1, 1, At, B1); PG8_BAR;
            PG8_LDB(B0, 1, 0); PG8_SCHED; PG8_LDA(At, 1, 0); PG8_STAGE(PG8_SA(0, 1), a2 + hstep, voffA);
            PG8_WAIT_L(8); PG8_BAR; PG8_WAIT_L(0); PG8_MMA(0, 0, At, B0); PG8_BAR; PG8_SCHED;
            PG8_LDB(B1, 1, 1); PG8_STAGE(PG8_SB(1, 0), b3, voffB);
            PG8_BAR; PG8_WAIT_L(0); PG8_MMA(0, 1, At, B1); PG8_BAR;
            PG8_LDA(At, 1, 1); PG8_STAGE(PG8_SA(1, 0), a3, voffA);
            PG8_BAR; PG8_WAIT_L(0); PG8_MMA(1, 0, At, B0); PG8_BAR; PG8_SCHED;
            PG8_STAGE(PG8_SB(1, 1), b3 + hstep, voffB);
            PG8_WAIT_V(6); PG8_BAR; PG8_MMA(1, 1, At, B1); PG8_BAR;
            }
        }
        if constexpr (ALIGN_EPI) { if (wr == 0) PG8_BAR; }
        if constexpr (!Epi::AFTER_DRAIN) { E(acc, cur, wr, wc, fr, fq); S.done(cur); }
        if (!has_next) break;
#pragma unroll
        for (int a = 0; a < 2; ++a)
#pragma unroll
            for (int b = 0; b < 2; ++b)
#pragma unroll
                for (int m = 0; m < 4; ++m)
#pragma unroll
                    for (int n = 0; n < 2; ++n) acc[a][b][m][n] = (f32x4){0.f, 0.f, 0.f, 0.f};
        cur = nxt; cA = nA; cB = nB; ++ui;
        if constexpr (ALIGN_EPI) { if (wr == 1) PG8_BAR; }
    }
    PG8_WAIT_V(0);
    if constexpr (!ALIGN_EPI) { if (wr == 0) PG8_BAR; }
    PG8_BAR;
    if constexpr (Epi::AFTER_DRAIN) { E.fused(acc, cur, wr, wc, fr, fq, lds, wid, lane); S.done(cur); }
#undef PG8_SA
#undef PG8_SB
#undef PG8_STAGE
#undef PG8_LDA
#undef PG8_LDB
#undef PG8_MMA
#undef PG8_WAIT_V
#undef PG8_WAIT_L
#undef PG8_BAR
#undef PG8_SCHED
}
}
#define XB_TMO      128
#define XB_XCNT(j)  (256  + 64 * (j))
#define XB_XSUB(j)  (1280 + 64 * (j))
#define XB_XGEN(j)  (2304 + 64 * (j))
#define XB_TOP      3328
#define XB_TOPGEN   3392
#define XCD_BAR_WORDS 3456
#define XB_SPIN_CAP (1u << 18)

__device__ __forceinline__ unsigned xb_ld(unsigned* p)              { return __hip_atomic_load(p, __ATOMIC_RELAXED, __HIP_MEMORY_SCOPE_AGENT); }
__device__ __forceinline__ unsigned xb_add(unsigned* p, unsigned v) { return __hip_atomic_fetch_add(p, v, __ATOMIC_RELAXED, __HIP_MEMORY_SCOPE_AGENT); }
__device__ __forceinline__ unsigned xb_xcc_id() { return (unsigned)__builtin_amdgcn_s_getreg((3 << 11) | 20) & 0xFu; }
#define XB_SPIN(cond, bar) do { unsigned _sp = 0; while (cond) { __builtin_amdgcn_s_sleep(1); \
    if ((++_sp & 255u) == 0u) { if (xb_ld(&(bar)[XB_TMO])) break; if (_sp > XB_SPIN_CAP) { atomicAdd(&(bar)[XB_TMO], 1u); break; } } } } while (0)

struct XcdBarrier {
    unsigned* bar; unsigned x;
    volatile LAS unsigned* st;
};

__device__ __forceinline__ XcdBarrier xcd_barrier_post(unsigned* bar, volatile LAS unsigned* st) {
    XcdBarrier b; b.bar = bar; b.x = xb_xcc_id(); b.st = st;
    if (threadIdx.x == 0) (void)xb_add(&bar[XB_XCNT(b.x)], 1u);
    return b;
}
__device__ __forceinline__ void xcd_barrier_complete(unsigned* bar, unsigned x, unsigned& nloc, unsigned& nx) {
    const unsigned G = gridDim.x * gridDim.y * gridDim.z;
    unsigned sum, cnt, mine, sp = 0u;
    for (;;) {
        sum = 0u; cnt = 0u; mine = 0u;
#pragma unroll
        for (unsigned j = 0; j < 16; ++j) { const unsigned c = xb_ld(&bar[XB_XCNT(j)]); sum += c; cnt += (c > 0u) ? 1u : 0u; mine = (j == x) ? c : mine; }
        if (sum == G) break;
        __builtin_amdgcn_s_sleep(1);
        if ((++sp & 255u) == 0u) { if (xb_ld(&bar[XB_TMO])) break; if (sp > XB_SPIN_CAP) { atomicAdd(&bar[XB_TMO], 1u); break; } }
    }
    nloc = mine > 0u ? mine : 1u; nx = cnt > 0u ? cnt : 1u;
}

__device__ __forceinline__ void xcd_barrier(const XcdBarrier& b) {
    asm volatile("s_waitcnt vmcnt(0)" ::: "memory");
    __syncthreads();
    if (threadIdx.x == 0) {
        unsigned* bar = b.bar;
        __builtin_amdgcn_s_waitcnt(0);
        unsigned nloc = b.st[0], nx = b.st[1];
        if (nloc == 0u) { xcd_barrier_complete(bar, b.x, nloc, nx); b.st[0] = nloc; b.st[1] = nx; }
        const unsigned old = xb_add(&bar[XB_XSUB(b.x)], 1u);
        const unsigned gen = old / nloc;
        if (old + 1u == (gen + 1u) * nloc) {
            __builtin_amdgcn_fence(__ATOMIC_RELEASE, "agent");
            asm volatile("s_waitcnt vmcnt(0)" ::: "memory");
            const unsigned og = xb_add(&bar[XB_TOP], 1u);
            const unsigned tg = og / nx;
            if (og + 1u == (tg + 1u) * nx) xb_add(&bar[XB_TOPGEN], 1u);
            else XB_SPIN(xb_ld(&bar[XB_TOPGEN]) == tg, bar);
            __builtin_amdgcn_fence(__ATOMIC_ACQUIRE, "agent");
            xb_add(&bar[XB_XGEN(b.x)], 1u);
            asm volatile("s_waitcnt vmcnt(0)" ::: "memory");
        } else {
            XB_SPIN(xb_ld(&bar[XB_XGEN(b.x)]) == gen, bar);
            __builtin_amdgcn_fence(__ATOMIC_ACQUIRE, "agent");
            asm volatile("s_waitcnt vmcnt(0)" ::: "memory");
        }
    }
    __syncthreads();
}

typedef unsigned short bf16_t;
typedef short bf16x8 __attribute__((ext_vector_type(8)));
typedef float f32x4 __attribute__((ext_vector_type(4)));
typedef float f32x16 __attribute__((ext_vector_type(16)));
typedef unsigned u32x4 __attribute__((ext_vector_type(4)));
typedef unsigned u32x2 __attribute__((ext_vector_type(2)));

constexpr int DM = 2048, SEQ = 4096, NB = 2, MP = NB * SEQ  , MS = 32  , MT = MP + MS;
constexpr int INW = 6144, AW = 1024, NH = 16, HD = 64, BUF = 2048, DB = 8, DT = 4, PH = 15, PW = 1024;
constexpr int C_Q = 0, C_K = 1024, C_V = 2048, C_GA = 3072, C_U = 4096, C_GP = 5120;
constexpr float EPS = 1e-6f;
constexpr float LOG2E = 1.4426950408889634f;

constexpr size_t O_YP = 0, O_YS = 16777216, O_KP = 16842752, O_VP = 21037056, O_PP = 25231360, O_KS = 25262080, O_VS = 42039296, O_PS = 58816512;

constexpr size_t MiB = 1u << 20;
constexpr size_t WS_CNT = 0  , WS_BAR = 65536, CTL_ZERO_BYTES = 131072, WS_SLOTS = 1 * MiB  , WS_WIN = 2 * MiB, WS_WOUT = 26 * MiB, WS_WPOOL = 34 * MiB, WS_XN = 36 * MiB, WS_Z = 70 * MiB, WS_MIX = 168 * MiB,
                 WS_POOLED = 202 * MiB, WS_POOLEDS = 219 * MiB, WS_KC = 220 * MiB, WS_VC = 238 * MiB;

constexpr int LDS_BYTES = 155648;
#ifndef PHM
#define PHM 63
#endif
#ifndef PHDUP
#define PHDUP 0
#endif
#ifndef SYNCDUP
#define SYNCDUP 1
#endif
#define GRID_SYNC() do { for (int s_ = 0; s_ < SYNCDUP; ++s_) xcd_barrier(xbar); } while (0)

struct Args {
    const float* x_prompt; const float* x_sample; const float* cache_k; const float* cache_v; const float* state_pool;
    const float* norm_g; const float* w_in; const float* w_pool; const float* pool_scale; const float* w_out; const float* final_g;
    float* out; unsigned char* ws;
};

__device__ __forceinline__ int otid(int wave_s) { int l; asm volatile("v_mbcnt_lo_u32_b32 %0, -1, 0\n\tv_mbcnt_hi_u32_b32 %0, -1, %0" : "=v"(l)); return wave_s * 64 + l; }
__device__ __forceinline__ int osgpr(int v) { asm volatile("" : "+s"(v)); return v; }
__device__ __forceinline__ unsigned f2bf(float f) { unsigned u = __builtin_bit_cast(unsigned, f); return (u + 0x7fffu + ((u >> 16) & 1u)) >> 16; }
typedef float f32x2_t __attribute__((ext_vector_type(2))); typedef __bf16 bf16x2_t __attribute__((ext_vector_type(2)));
__device__ __forceinline__ unsigned pk2(float lo, float hi) { f32x2_t v = {lo, hi}; bf16x2_t b = __builtin_convertvector(v, bf16x2_t); return __builtin_bit_cast(unsigned, b); }
__device__ __forceinline__ float bflo(unsigned w) { return __builtin_bit_cast(float, w << 16); }
__device__ __forceinline__ float bfhi(unsigned w) { return __builtin_bit_cast(float, w & 0xffff0000u); }
__device__ __forceinline__ float silu(float v) { return v * __builtin_amdgcn_rcpf(1.f + __builtin_amdgcn_exp2f(-1.4426950408889634f * v)); }
__device__ __forceinline__ float wave_sum(float v) {
#pragma unroll
    for (int o = 1; o < 64; o <<= 1) v += __shfl_xor(v, o);
    return v;
}
__device__ __forceinline__ float wave_max(float v) {
#pragma unroll
    for (int o = 1; o < 64; o <<= 1) v = fmaxf(v, __shfl_xor(v, o));
    return v;
}

__device__ __forceinline__ void p0_transpose_item(const float* W, int K, int N, bf16_t* WT, LAS float* scr, int item, int lane) {
    const int nblk = N / 32, kb = item / nblk, nb = item % nblk, k0 = 64 * kb, n0 = 32 * nb;
    f32x4 v[8];
#pragma unroll
    for (int i = 0; i < 8; ++i) v[i] = __builtin_nontemporal_load((const f32x4*)(W + (size_t)(k0 + 8 * i + (lane >> 3)) * N + n0 + 4 * (lane & 7)));
#pragma unroll
    for (int i = 0; i < 8; ++i) { LAS float* d = scr + (8 * i + (lane >> 3)) * 33 + 4 * (lane & 7); d[0] = v[i].x; d[1] = v[i].y; d[2] = v[i].z; d[3] = v[i].w; }
    asm volatile("s_waitcnt lgkmcnt(0)" ::: "memory");
    const int c = lane & 7;
#pragma unroll
    for (int j = 0; j < 4; ++j) { const int n = (lane >> 3) + 8 * j; const LAS float* s = scr + (8 * c) * 33 + n;
        u32x4 o; o.x = pk2(s[0 * 33], s[1 * 33]); o.y = pk2(s[2 * 33], s[3 * 33]); o.z = pk2(s[4 * 33], s[5 * 33]); o.w = pk2(s[6 * 33], s[7 * 33]);
        *(u32x4*)(WT + (size_t)(n0 + n) * K + k0 + 8 * c) = o; }
    asm volatile("s_waitcnt lgkmcnt(0)" ::: "memory");
}

__device__ __forceinline__ void rms_row_to_bf16(const float* xrow, const float* g, bf16_t* orow, int lane) {
    const f32x4* xr = (const f32x4*)xrow + lane; const f32x4* gr = (const f32x4*)g + lane;
    f32x4 v[8]; float s = 0.f;
#pragma unroll
    for (int j = 0; j < 8; ++j) { v[j] = __builtin_nontemporal_load(xr + 64 * j); s += (v[j].x * v[j].x + v[j].y * v[j].y) + (v[j].z * v[j].z + v[j].w * v[j].w); }
    const float rs = 1.f / sqrtf(wave_sum(s) * (1.f / DM) + EPS);
    u32x2* o8 = (u32x2*)orow + lane;
#pragma unroll
    for (int j = 0; j < 8; ++j) { const f32x4 gg = gr[64 * j]; u32x2 w; w.x = pk2(v[j].x * rs * gg.x, v[j].y * rs * gg.y); w.y = pk2(v[j].z * rs * gg.z, v[j].w * rs * gg.w); o8[64 * j] = w; }
}

struct EpiZ {
    static constexpr bool PERM = true, AFTER_DRAIN = false;
    bf16_t* Z; float* out; bf16_t* KC; bf16_t* VC;
    __device__ __forceinline__ void operator()(const pg8::f32x4 (&acc)[2][2][4][2], const pg8::Unit& u, int wr, int wc, int fr_, int fq_) const {
        int l_ = (fq_ << 4) | fr_; asm volatile("" : "+v"(l_)); const int fr = l_ & 15, fq = l_ >> 4;
        const int row0 = u.pm * 256 + wr * 64 + fr, col0 = u.pn * 256 + wc * 32 + 8 * fq;
        const int b = u.pm >> 4, pt = u.pm & 15;
        float* fo = nullptr;
        if (pt >= 8) { if (u.pn >= 4 && u.pn < 8) fo = out + O_KP + (col0 - C_K); else if (u.pn >= 8 && u.pn < 12) fo = out + O_VP + (col0 - C_V); }
        const bool pool = (pt == 15) && (u.pn >= 16) && (u.pn < 20);
        bf16_t* cz = nullptr; int ck0 = 0;
        if (u.pn >= 4 && u.pn < 8) { cz = KC; ck0 = col0 - C_K; } else if (u.pn >= 8 && u.pn < 12) { cz = VC; ck0 = col0 - C_V; }
#pragma unroll
        for (int ai = 0; ai < 2; ++ai)
#pragma unroll
            for (int m = 0; m < 4; ++m) {
                const int row = row0 + ai * 128 + m * 16; const int pos = row & (SEQ - 1);
                bf16_t* rowp = Z + (size_t)row * INW + col0;
#pragma unroll
                for (int bj = 0; bj < 2; ++bj) {
                    const pg8::f32x4 v0 = acc[ai][bj][m][0], v1 = acc[ai][bj][m][1];
                    u32x4 w; w.x = pk2(v0[0], v0[1]); w.y = pk2(v0[2], v0[3]); w.z = pk2(v1[0], v1[1]); w.w = pk2(v1[2], v1[3]);
                    if (cz) { const int ck = ck0 + bj * 128; *(u32x4*)(cz + (((size_t)(b * NH + (ck >> 6)) * SEQ + pos) * HD + (ck & 63))) = w; }
                    else *(u32x4*)(rowp + bj * 128) = w;
                    if (fo) { float* p = fo + (size_t)(b * BUF + pos - BUF) * AW + bj * 128; *(pg8::f32x4*)p = v0; *(pg8::f32x4*)(p + 4) = v1; }
                    if (pool && pos >= SEQ - PH) { float* p = out + O_PP + (size_t)(b * PH + pos - (SEQ - PH)) * PW + (col0 - C_U) + bj * 128; *(pg8::f32x4*)p = v0; *(pg8::f32x4*)(p + 4) = v1; }
                }
            }
    }
};

#define NORM_SPIN_CAP (1u << 22)
struct EpiYN {
    static constexpr bool PERM = false, AFTER_DRAIN = true;
    const float* x; float* y; const float* gfin; float* slots; unsigned* cnt;
    __device__ __forceinline__ void fused(pg8::f32x4 (&acc)[2][2][4][2], const pg8::Unit& u, int wr, int wc, int fr, int fq, LAS unsigned char* lds, int wid, int lane) const {
        LAS float* P = (LAS float*)lds;
        LAS float* S = (LAS float*)(lds + 4096);
        const int row0 = u.pm * 256 + wr * 64 + fr, col0 = u.pn * 256 + wc * 32 + 4 * fq;
#pragma unroll
        for (int ai = 0; ai < 2; ++ai)
#pragma unroll
            for (int m = 0; m < 4; ++m) {
                const int row = row0 + ai * 128 + m * 16; float ss = 0.f;
#pragma unroll
                for (int bj = 0; bj < 2; ++bj)
#pragma unroll
                    for (int n = 0; n < 2; ++n) {
                        const f32x4 xv = __builtin_nontemporal_load((const f32x4*)(x + (size_t)row * DM + col0 + bj * 128 + n * 16));
                        pg8::f32x4 hv = acc[ai][bj][m][n]; hv[0] += xv.x; hv[1] += xv.y; hv[2] += xv.z; hv[3] += xv.w; acc[ai][bj][m][n] = hv;
                        ss += (hv[0] * hv[0] + hv[1] * hv[1]) + (hv[2] * hv[2] + hv[3] * hv[3]);
                    }
                ss += __shfl_xor(ss, 16); ss += __shfl_xor(ss, 32);
                if (fq == 0) P[(ai * 128 + wr * 64 + m * 16 + fr) * 4 + wc] = ss;
                if (m & 1) asm volatile("" ::: "memory");
            }
        asm volatile("s_waitcnt lgkmcnt(0)" ::: "memory"); __builtin_amdgcn_s_barrier(); asm volatile("" ::: "memory");
        const int t = wid * 64 + lane;
        if (t < 256) { const float s = (P[t * 4] + P[t * 4 + 1]) + (P[t * 4 + 2] + P[t * 4 + 3]);
            __hip_atomic_store(slots + (size_t)(u.pm * 256 + t) * 8 + u.pn, s, __ATOMIC_RELAXED, __HIP_MEMORY_SCOPE_AGENT); }
        asm volatile("s_waitcnt vmcnt(0)" ::: "memory");
        if (t < 256 && lane == 0) __hip_atomic_fetch_add(cnt + 64 * u.pm, 1u, __ATOMIC_RELAXED, __HIP_MEMORY_SCOPE_AGENT);
        if (wid == 0) { unsigned sp = 0;
            while ((unsigned)__builtin_amdgcn_readfirstlane(__hip_atomic_load(cnt + 64 * u.pm, __ATOMIC_RELAXED, __HIP_MEMORY_SCOPE_AGENT)) < 32u) { __builtin_amdgcn_s_sleep(2); if (++sp > NORM_SPIN_CAP) break; }
            __builtin_amdgcn_fence(__ATOMIC_ACQUIRE, "agent"); }
        asm volatile("s_waitcnt vmcnt(0) lgkmcnt(0)" ::: "memory"); __builtin_amdgcn_s_barrier(); asm volatile("" ::: "memory");
        if (t < 256) { const float* sl = slots + (size_t)(u.pm * 256 + t) * 8; float tot = 0.f;
#pragma unroll
            for (int k = 0; k < 8; ++k) tot += __hip_atomic_load(sl + k, __ATOMIC_RELAXED, __HIP_MEMORY_SCOPE_AGENT);
            S[t] = 1.f / sqrtf(tot * (1.f / DM) + EPS); }
        asm volatile("s_waitcnt vmcnt(0) lgkmcnt(0)" ::: "memory"); __builtin_amdgcn_s_barrier(); asm volatile("" ::: "memory");
        f32x4 gg[2][2];
#pragma unroll
        for (int bj = 0; bj < 2; ++bj)
#pragma unroll
            for (int n = 0; n < 2; ++n) gg[bj][n] = *(const f32x4*)(gfin + col0 + bj * 128 + n * 16);
#pragma unroll
        for (int ai = 0; ai < 2; ++ai)
#pragma unroll
            for (int m = 0; m < 4; ++m) {
                const int rl = ai * 128 + wr * 64 + m * 16 + fr; const float rs = S[rl]; const int row = u.pm * 256 + rl;
#pragma unroll
                for (int bj = 0; bj < 2; ++bj)
#pragma unroll
                    for (int n = 0; n < 2; ++n) { const pg8::f32x4 hv = acc[ai][bj][m][n]; f32x4 o; o.x = hv[0] * rs * gg[bj][n].x; o.y = hv[1] * rs * gg[bj][n].y; o.z = hv[2] * rs * gg[bj][n].z; o.w = hv[3] * rs * gg[bj][n].w;
                        *(f32x4*)(y + (size_t)row * DM + col0 + bj * 128 + n * 16) = o; }
            }
    }
};

template <class Epi>
__device__ __forceinline__ void small_gemm(LAS unsigned char* lds, const bf16_t* A, const bf16_t* Bt, int ntiles, int K, int tile0, int tstride, const Epi& E, const int tid) {
    const int  wid = tid >> 6, lane = tid & 63, fr = lane & 15, fq = lane >> 4;
    LAS float* red = (LAS float*)lds;
    const int kw = K >> 3, k0 = wid * kw;
    for (int tile = tile0; tile < ntiles; tile += tstride) {
        const int n0 = tile * 32;
        f32x4 acc[2][2];
#pragma unroll
        for (int a = 0; a < 2; ++a)
#pragma unroll
            for (int b = 0; b < 2; ++b) acc[a][b] = (f32x4){0.f, 0.f, 0.f, 0.f};
        const bf16_t* ap = A + (size_t)fr * K + k0 + fq * 8;
        const bf16_t* bp = Bt + (size_t)(n0 + fr) * K + k0 + fq * 8;
#pragma unroll 4
        for (int kk = 0; kk < kw; kk += 32) {
            const bf16x8 a0 = *(const bf16x8*)(ap + kk), a1 = *(const bf16x8*)(ap + (size_t)16 * K + kk);
            const bf16x8 b0 = *(const bf16x8*)(bp + kk), b1 = *(const bf16x8*)(bp + (size_t)16 * K + kk);
            acc[0][0] = __builtin_amdgcn_mfma_f32_16x16x32_bf16(a0, b0, acc[0][0], 0, 0, 0);
            acc[0][1] = __builtin_amdgcn_mfma_f32_16x16x32_bf16(a0, b1, acc[0][1], 0, 0, 0);
            acc[1][0] = __builtin_amdgcn_mfma_f32_16x16x32_bf16(a1, b0, acc[1][0], 0, 0, 0);
            acc[1][1] = __builtin_amdgcn_mfma_f32_16x16x32_bf16(a1, b1, acc[1][1], 0, 0, 0);
        }
#pragma unroll
        for (int mi = 0; mi < 2; ++mi)
#pragma unroll
            for (int ni = 0; ni < 2; ++ni)
#pragma unroll
                for (int j = 0; j < 4; ++j) red[wid * 1024 + (mi * 16 + fq * 4 + j) * 32 + ni * 16 + fr] = acc[mi][ni][j];
        __syncthreads();
#pragma unroll
        for (int k = 0; k < 2; ++k) { const int e = tid + 512 * k; float s = 0.f;
#pragma unroll
            for (int w = 0; w < 8; ++w) s += red[w * 1024 + e];
            E(e >> 5, n0 + (e & 31), s); }
        __syncthreads();
    }
}
struct SEpiZ {
    bf16_t* Z; float* out;
    __device__ __forceinline__ void operator()(int row, int col, float v) const {
        Z[(size_t)(MP + row) * INW + col] = (bf16_t)f2bf(v);
        const int b = row >> 2, t = row & 3;
        if (col >= C_K && col < C_V) out[O_KS + (size_t)(b * BUF + BUF - DT + t) * AW + (col - C_K)] = v;
        else if (col >= C_V && col < C_GA) out[O_VS + (size_t)(b * BUF + BUF - DT + t) * AW + (col - C_V)] = v;
        else if (col >= C_U && col < C_GP) out[O_PS + (size_t)(b * PH + PH - DT + t) * PW + (col - C_U)] = v;
    }
};
__device__ __forceinline__ void sample_out_unit(LAS unsigned char* lds, const bf16_t* A, const bf16_t* Bt, const float* xs, float* ys, const float* gfin, float* slots, unsigned* cnt, int tile, int tid) {
    const int wid = tid >> 6, lane = tid & 63, fr = lane & 15, fq = lane >> 4;
    LAS float* red = (LAS float*)lds;
    LAS float* S = (LAS float*)(lds + 32768);
    constexpr int K = DM; const int kw = K >> 3, k0 = wid * kw, n0 = tile * 32;
    f32x4 acc[2][2];
#pragma unroll
    for (int a = 0; a < 2; ++a)
#pragma unroll
        for (int b = 0; b < 2; ++b) acc[a][b] = (f32x4){0.f, 0.f, 0.f, 0.f};
    const bf16_t* ap = A + (size_t)fr * K + k0 + fq * 8;
    const bf16_t* bp = Bt + (size_t)(n0 + fr) * K + k0 + fq * 8;
#pragma unroll 4
    for (int kk = 0; kk < kw; kk += 32) {
        const bf16x8 a0 = *(const bf16x8*)(ap + kk), a1 = *(const bf16x8*)(ap + (size_t)16 * K + kk);
        const bf16x8 b0 = *(const bf16x8*)(bp + kk), b1 = *(const bf16x8*)(bp + (size_t)16 * K + kk);
        acc[0][0] = __builtin_amdgcn_mfma_f32_16x16x32_bf16(a0, b0, acc[0][0], 0, 0, 0);
        acc[0][1] = __builtin_amdgcn_mfma_f32_16x16x32_bf16(a0, b1, acc[0][1], 0, 0, 0);
        acc[1][0] = __builtin_amdgcn_mfma_f32_16x16x32_bf16(a1, b0, acc[1][0], 0, 0, 0);
        acc[1][1] = __builtin_amdgcn_mfma_f32_16x16x32_bf16(a1, b1, acc[1][1], 0, 0, 0);
    }
#pragma unroll
    for (int mi = 0; mi < 2; ++mi)
#pragma unroll
        for (int ni = 0; ni < 2; ++ni)
#pragma unroll
            for (int j = 0; j < 4; ++j) red[wid * 1024 + (mi * 16 + fq * 4 + j) * 32 + ni * 16 + fr] = acc[mi][ni][j];
    __syncthreads();
    float hv[2];
#pragma unroll
    for (int k = 0; k < 2; ++k) { const int e = tid + 512 * k, row = e >> 5, col = n0 + (e & 31); float s = 0.f;
#pragma unroll
        for (int w = 0; w < 8; ++w) s += red[w * 1024 + e];
        const float h = xs[(size_t)row * DM + col] + s; hv[k] = h;
        float ss = h * h;
#pragma unroll
        for (int o = 1; o < 32; o <<= 1) ss += __shfl_xor(ss, o);
        if ((lane & 31) == 0) __hip_atomic_store(slots + row * 64 + tile, ss, __ATOMIC_RELAXED, __HIP_MEMORY_SCOPE_AGENT); }
    asm volatile("s_waitcnt vmcnt(0)" ::: "memory");
    __syncthreads();
    if (tid == 0) { __hip_atomic_fetch_add(cnt, 1u, __ATOMIC_RELAXED, __HIP_MEMORY_SCOPE_AGENT); }
    if (wid == 0) { unsigned sp = 0;
        while ((unsigned)__builtin_amdgcn_readfirstlane(__hip_atomic_load(cnt, __ATOMIC_RELAXED, __HIP_MEMORY_SCOPE_AGENT)) < 64u) { __builtin_amdgcn_s_sleep(2); if (++sp > NORM_SPIN_CAP) break; }
        __builtin_amdgcn_fence(__ATOMIC_ACQUIRE, "agent");
        if (lane < 32) { float tot = 0.f;
#pragma unroll 8
            for (int k = 0; k < 64; ++k) tot += __hip_atomic_load(slots + lane * 64 + k, __ATOMIC_RELAXED, __HIP_MEMORY_SCOPE_AGENT);
            S[lane] = 1.f / sqrtf(tot * (1.f / DM) + EPS); } }
    __syncthreads();
#pragma unroll
    for (int k = 0; k < 2; ++k) { const int e = tid + 512 * k, row = e >> 5, col = n0 + (e & 31);
        ys[(size_t)row * DM + col] = hv[k] * S[row] * gfin[col]; }
    __syncthreads();
}

constexpr int CP_PER_B = (BUF - DT) * AW / 4, CP_N = DB * CP_PER_B, CP_ATT = 256 * 8 * 6 * 512  ;
__device__ __forceinline__ void cp_addr(const Args& a, int i, const f32x4*& src, f32x4*& dst) {
    const bool isv = i >= CP_N; const int ii = isv ? i - CP_N : i; const int b = ii / CP_PER_B, o = ii - b * CP_PER_B;
    const size_t d = (size_t)b * (BUF * AW / 4) + o;
    src = (const f32x4*)(isv ? a.cache_v : a.cache_k) + d + DT * AW / 4;
    dst = (f32x4*)(a.out + (isv ? O_VS : O_KS)) + d;
}

typedef short s16x4 __attribute__((ext_vector_type(4)));
__device__ __forceinline__ s16x4 vtr(const LAS unsigned char* p) { return __builtin_bit_cast(s16x4, __builtin_amdgcn_ds_read_tr16_b64_v4i16((LAS s16x4*)p)); }
__device__ __forceinline__ int crow(int r, int hi) { return (r & 3) + 8 * (r >> 2) + 4 * hi; }
constexpr int OSH_STRIDE = 144, OSH_BYTES = 512 * OSH_STRIDE  , LSH_OFF = OSH_BYTES, VSH_OFF = LSH_OFF + 2048, VSH_WAVE = 32 * 144  ;
constexpr int KSH2_OFF = VSH_OFF + 8 * VSH_WAVE  ;
static_assert(KSH2_OFF + 8 * VSH_WAVE <= LDS_BYTES - 64, "attention LDS map");

__device__ __forceinline__ void attn_prompt_unit(LAS unsigned char* lds, const bf16_t* Z, bf16_t* MIX, int b, int h, int blk, const int wid  , const Args& a, const int unit, const bf16_t* KC, const bf16_t* VC) {
    LAS unsigned char* Osh = lds;
    LAS float* Lsh = (LAS float*)(lds + LSH_OFF);
    LAS unsigned char* Vsh = lds + VSH_OFF + wid * VSH_WAVE;
    const int t0 = blk * 512; const size_t rowbase = (size_t)b * SEQ;
    const char* Kb = (const char*)KC + (size_t)(b * NH + h) * SEQ * (HD * 2); const char* Vb = (const char*)VC + (size_t)(b * NH + h) * SEQ * (HD * 2);
    const float SC = 0.125f * LOG2E;
#pragma unroll 1
    for (int p = 0; p < 3; ++p) {
        const int dil = 1 << (2 * p);
#pragma unroll 1
        for (int gi = 0; gi < 2; ++gi) {
            const int g = wid * 2 + gi;
            const int lane = otid(0); const int r = lane & 31, hh = lane >> 5;
            const int cpbase = (((unit * 8 + wid) * 6) + (p * 2 + gi)) * 512; f32x4 cpv[4]; unsigned cpo[4];
            const bool cp_isv = cpbase >= CP_N; const int cp_ii0 = cp_isv ? cpbase - CP_N : cpbase, cp_vb0 = cp_ii0 / CP_PER_B, cp_next = (cp_vb0 + 1) * CP_PER_B;
            const char* cp_src = (const char*)(cp_isv ? a.cache_v : a.cache_k) + (size_t)DT * AW * 4; char* cp_dst = (char*)(a.out + (cp_isv ? O_VS : O_KS));
#define CP_OFF(K_) ({ const int ii_ = cp_ii0 + (K_) + lane; (unsigned)(ii_ + (ii_ >= cp_next ? cp_vb0 + 1 : cp_vb0) * 1024) * 16u; })
            const char* Zb = (const char*)Z; constexpr unsigned ROWB = INW * 2; const unsigned rb0 = (unsigned)rowbase;
            const LAS unsigned char* vtb = Vsh + (4 * hh + ((lane & 15) >> 2)) * 144 + (16 * ((lane >> 4) & 1) + 4 * (lane & 3)) * 2;
            const int qbase = t0 + (g & (dil - 1)) + dil * 32 * (g >> (2 * p));
            const int qpos = qbase + dil * r;
            const unsigned qoff = (rb0 + (unsigned)qpos) * ROWB + (unsigned)((C_Q + h * HD + hh * 8) * 2);
            bf16x8 bq[4];
#pragma unroll
            for (int s = 0; s < 4; ++s) bq[s] = *(const bf16x8*)(Zb + (size_t)qoff + 32 * s);
            f32x16 X[5];
            {
                u32x4 kr[5][4];
                const int ka0 = qbase + dil * ((lane >> 3) - 128);
                const unsigned kcolb = (unsigned)((C_K + h * HD + (lane & 7) * 8) * 2);
#pragma unroll
                for (int T = 0; T < 5; ++T)
#pragma unroll
                    for (int c = 0; c < 4; ++c) { const int kpos = ka0 + (32 * T + 8 * c) * dil;
                        kr[T][c] = *(const u32x4*)(Kb + (size_t)((unsigned)(kpos < 0 ? 0 : kpos) * 128u + (unsigned)((lane & 7) * 16))); }
#pragma unroll
                for (int u = 0; u < 4; ++u) { cpo[u] = CP_OFF(64 * u); cpv[u] = __builtin_nontemporal_load((const f32x4*)(cp_src + (size_t)cpo[u])); }
                __builtin_amdgcn_sched_barrier(0);
                LAS unsigned char* Ksh2 = lds + KSH2_OFF + wid * VSH_WAVE;
#pragma unroll
                for (int T = 0; T < 5; ++T) {
                    LAS unsigned char* kb = (T & 1) ? Ksh2 : Vsh;
#pragma unroll
                    for (int c = 0; c < 4; ++c) *(LAS u32x4*)(kb + ((lane >> 3) + 8 * c) * 144 + (lane & 7) * 16) = kr[T][c];
                    f32x16 x;
#pragma unroll
                    for (int i = 0; i < 16; ++i) x[i] = 0.f;
#pragma unroll
                    for (int s = 0; s < 4; ++s) { const bf16x8 ka = *(const LAS bf16x8*)(kb + r * 144 + 32 * s + 16 * hh);
                        x = __builtin_amdgcn_mfma_f32_32x32x16_bf16(ka, bq[s], x, 0, 0, 0); }
                    X[T] = x;
                }
                __builtin_amdgcn_sched_barrier(0);
            }
            u32x4 vf[5][4];
            const int va0 = qbase + dil * ((lane >> 3) - 128); const unsigned vcolb = (unsigned)((C_V + h * HD + (lane & 7) * 8) * 2);
#pragma unroll
            for (int T = 0; T < 3; ++T)
#pragma unroll
                for (int c = 0; c < 4; ++c) { const int kposn = va0 + (32 * T + 8 * c) * dil;
                    vf[T][c] = *(const u32x4*)(Vb + (size_t)((unsigned)(kposn < 0 ? 0 : kposn) * 128u + (unsigned)((lane & 7) * 16))); }
#pragma unroll
            for (int u = 0; u < 4; ++u) __builtin_nontemporal_store(cpv[u], (f32x4*)(cp_dst + (size_t)cpo[u]));
#pragma unroll
            for (int u = 0; u < 4; ++u) { cpo[u] = CP_OFF(256 + 64 * u); cpv[u] = __builtin_nontemporal_load((const f32x4*)(cp_src + (size_t)cpo[u])); }
            __builtin_amdgcn_sched_barrier(0);
            const int nneg = 128 - (qbase >> (2 * p));
            const int nlo = (r > nneg ? r : nneg) - 4 * hh, nhi = r + 128 - 4 * hh;
            const int tneg = (nneg > 0) ? ((nneg - 1) >> 5) : -1;
            float mraw = -INFINITY;
#pragma unroll
            for (int T = 0; T < 5; ++T) {
                if (T == 0 || T == 4 || T <= tneg) {
#pragma unroll
                    for (int i = 0; i < 16; ++i) {
                        const int nc = 32 * T + (i & 3) + 8 * (i >> 2);
                        const bool valid = (T == 4 ? nc <= nhi : true) && (T < 4 ? nc >= nlo : true);
                        const float v = valid ? X[T][i] : -INFINITY; X[T][i] = v; mraw = fmaxf(mraw, v);
                    }
                } else {
#pragma unroll
                    for (int i = 0; i < 16; ++i) mraw = fmaxf(mraw, X[T][i]);
                }
            }
            { auto rr = __builtin_amdgcn_permlane32_swap(__float_as_uint(mraw), __float_as_uint(mraw), false, false); mraw = fmaxf(__uint_as_float(rr[0]), __uint_as_float(rr[1])); }
            const float m = mraw * SC, negm = -m;
            float l = 0.f;
#pragma unroll
            for (int T = 0; T < 5; ++T)
#pragma unroll
                for (int i = 0; i < 16; ++i) { const float pe = __builtin_amdgcn_exp2f(__builtin_fmaf(X[T][i], SC, negm)); X[T][i] = pe; l += pe; }
            { auto rr = __builtin_amdgcn_permlane32_swap(__float_as_uint(l), __float_as_uint(l), false, false); l = __uint_as_float(rr[0]) + __uint_as_float(rr[1]); }
            __builtin_amdgcn_sched_barrier(0);
            f32x16 o0, o1;
#pragma unroll
            for (int i = 0; i < 16; ++i) { o0[i] = 0.f; o1[i] = 0.f; }
#pragma unroll
            for (int T = 0; T < 5; ++T) {
                if (T == 1) {
#pragma unroll
                    for (int T2 = 3; T2 < 5; ++T2)
#pragma unroll
                        for (int c = 0; c < 4; ++c) { const int kposn = va0 + (32 * T2 + 8 * c) * dil;
                            vf[T2][c] = *(const u32x4*)(Vb + (size_t)((unsigned)(kposn < 0 ? 0 : kposn) * 128u + (unsigned)((lane & 7) * 16))); }
                }
#pragma unroll
                for (int c = 0; c < 4; ++c) { const int chunk = lane + 64 * c, vr = chunk >> 3, vc = chunk & 7;
                    *(LAS u32x4*)(Vsh + vr * 144 + vc * 16) = vf[T][c]; }
                __builtin_amdgcn_sched_barrier(0);
#pragma unroll
                for (int s2 = 0; s2 < 2; ++s2) {
                    bf16x8 pb;
#pragma unroll
                    for (int j = 0; j < 8; j += 2) { const unsigned w = pk2(X[T][8 * s2 + j], X[T][8 * s2 + j + 1]); pb[j] = (short)(w & 0xffffu); pb[j + 1] = (short)(w >> 16); }
                    const s16x4 a0lo = vtr(vtb + (16 * s2) * 144),      a0hi = vtr(vtb + (16 * s2 + 8) * 144);
                    const s16x4 a1lo = vtr(vtb + (16 * s2) * 144 + 64), a1hi = vtr(vtb + (16 * s2 + 8) * 144 + 64);
                    const bf16x8 va0 = (bf16x8){a0lo[0], a0lo[1], a0lo[2], a0lo[3], a0hi[0], a0hi[1], a0hi[2], a0hi[3]};
                    const bf16x8 va1 = (bf16x8){a1lo[0], a1lo[1], a1lo[2], a1lo[3], a1hi[0], a1hi[1], a1hi[2], a1hi[3]};
                    o0 = __builtin_amdgcn_mfma_f32_32x32x16_bf16(va0, pb, o0, 0, 0, 0);
                    o1 = __builtin_amdgcn_mfma_f32_32x32x16_bf16(va1, pb, o1, 0, 0, 0);
                }
                __builtin_amdgcn_sched_barrier(0);
            }
#pragma unroll
            for (int u = 0; u < 4; ++u) __builtin_nontemporal_store(cpv[u], (f32x4*)(cp_dst + (size_t)cpo[u]));
#undef CP_OFF
            const float inv = 1.f / l; float L2 = m + __builtin_amdgcn_logf(l);
            const int ql = qpos - t0;
            float wo = 0.f, wn = inv;
            if (p > 0) { const float Lold = Lsh[ql]; const float mx = fmaxf(Lold, L2);
                const float Ln = mx + __builtin_amdgcn_logf(__builtin_amdgcn_exp2f(Lold - mx) + __builtin_amdgcn_exp2f(L2 - mx));
                wo = __builtin_amdgcn_exp2f(Lold - Ln); wn = __builtin_amdgcn_exp2f(L2 - Ln) * inv; L2 = Ln; }
#pragma unroll
            for (int dh = 0; dh < 2; ++dh)
#pragma unroll
                for (int g4 = 0; g4 < 4; ++g4) {
                    LAS u32x2* op = (LAS u32x2*)(Osh + ql * OSH_STRIDE + (32 * dh + 8 * g4 + 4 * hh) * 2);
                    float v0, v1, v2, v3;
                    if (dh == 0) { v0 = o0[4 * g4] * wn; v1 = o0[4 * g4 + 1] * wn; v2 = o0[4 * g4 + 2] * wn; v3 = o0[4 * g4 + 3] * wn; }
                    else         { v0 = o1[4 * g4] * wn; v1 = o1[4 * g4 + 1] * wn; v2 = o1[4 * g4 + 2] * wn; v3 = o1[4 * g4 + 3] * wn; }
                    if (p > 0) { const u32x2 old = *op; v0 += bflo(old.x) * wo; v1 += bfhi(old.x) * wo; v2 += bflo(old.y) * wo; v3 += bfhi(old.y) * wo; }
                    u32x2 nw; nw.x = pk2(v0, v1); nw.y = pk2(v2, v3); *op = nw;
                }
            if (hh == 0) Lsh[ql] = L2;
        }
        __syncthreads();
    }
    const int tid = otid(wid);
#pragma unroll
    for (int it = 0; it < 8; ++it) { const int chunk = tid + 512 * it, row = chunk >> 3, c = chunk & 7;
        const u32x4 ov = *(const LAS u32x4*)(Osh + row * OSH_STRIDE + c * 16);
        const size_t grow = rowbase + t0 + row;
        const u32x4 gv = *(const u32x4*)(Z + grow * INW + C_GA + h * HD + c * 8);
        u32x4 w;
        w.x = pk2(bflo(ov.x) * silu(bflo(gv.x)), bfhi(ov.x) * silu(bfhi(gv.x)));
        w.y = pk2(bflo(ov.y) * silu(bflo(gv.y)), bfhi(ov.y) * silu(bfhi(gv.y)));
        w.z = pk2(bflo(ov.z) * silu(bflo(gv.z)), bfhi(ov.z) * silu(bfhi(gv.z)));
        w.w = pk2(bflo(ov.w) * silu(bflo(gv.w)), bfhi(ov.w) * silu(bfhi(gv.w)));
        *(u32x4*)(MIX + grow * DM + h * HD + c * 8) = w; }
    __syncthreads();
}

template <int W>
__device__ __forceinline__ void pooled_item(const bf16_t* up, bf16_t* pp, int row0, int pos0) {
    u32x4 R[W + 7];
#pragma unroll
    for (int k = 0; k < W + 7; ++k) { const int d = k - (W - 1);
        R[k] = (pos0 + d >= 0) ? *(const u32x4*)(up + (size_t)(row0 + d) * INW) : (u32x4){0u, 0u, 0u, 0u}; }
    float S[8];
#pragma unroll
    for (int c = 0; c < 8; ++c) S[c] = 0.f;
#pragma unroll
    for (int k = 0; k < W - 1; ++k) { S[0] += bflo(R[k].x); S[1] += bfhi(R[k].x); S[2] += bflo(R[k].y); S[3] += bfhi(R[k].y); S[4] += bflo(R[k].z); S[5] += bfhi(R[k].z); S[6] += bflo(R[k].w); S[7] += bfhi(R[k].w); }
#pragma unroll
    for (int j = 0; j < 8; ++j) {
        const u32x4 v = R[W - 1 + j], q = R[j];
        const float c[8] = {bflo(v.x), bfhi(v.x), bflo(v.y), bfhi(v.y), bflo(v.z), bfhi(v.z), bflo(v.w), bfhi(v.w)};
        const int pos = pos0 + j; const float icnt = 1.f / (float)((pos + 1 < W) ? pos + 1 : W);
        float o[8];
#pragma unroll
        for (int k = 0; k < 8; ++k) { S[k] += c[k]; o[k] = S[k] * icnt - c[k]; }
        u32x4 ov; ov.x = pk2(o[0], o[1]); ov.y = pk2(o[2], o[3]); ov.z = pk2(o[4], o[5]); ov.w = pk2(o[6], o[7]);
        *(u32x4*)(pp + (size_t)(row0 + j) * 256) = ov;
        S[0] -= bflo(q.x); S[1] -= bfhi(q.x); S[2] -= bflo(q.y); S[3] -= bfhi(q.y); S[4] -= bflo(q.z); S[5] -= bfhi(q.z); S[6] -= bflo(q.w); S[7] -= bfhi(q.w);
    }
}

template <int CH>
__device__ __forceinline__ void pool_tile16(LAS unsigned char* lds, const bf16x8 (&tf)[8]  , const bf16_t* zrow  , bf16_t* orow  ,
                                            const float* pool_scale, int g, int fr, int fq, int nt0, int nchunks) {
    u32x2 gvv[CH], gvn[CH]; f32x4 scv[CH], scn[CH];
#pragma unroll
    for (int k = 0; k < CH; ++k) { const int c = g * 256 + (nt0 + k) * 16 + 4 * fq; gvv[k] = *(const u32x2*)(zrow + C_GP + c); scv[k] = *(const f32x4*)(pool_scale + c); }
#pragma unroll 1
    for (int ch = 0; ch < nchunks; ++ch) {
        const int chn = (ch + 1 < nchunks) ? ch + 1 : ch;
#pragma unroll
        for (int k = 0; k < CH; ++k) { const int c = g * 256 + (nt0 + CH * chn + k) * 16 + 4 * fq; gvn[k] = *(const u32x2*)(zrow + C_GP + c); scn[k] = *(const f32x4*)(pool_scale + c); }
#pragma unroll
        for (int k = 0; k < CH; ++k) {
            const int nt = nt0 + CH * ch + k;
            f32x4 acc = (f32x4){0.f, 0.f, 0.f, 0.f};
#pragma unroll
            for (int s = 0; s < 8; ++s) { const bf16x8 wf = *(const LAS bf16x8*)(lds + (nt * 16 + fr) * 528 + (32 * s + 8 * fq) * 2);
                acc = __builtin_amdgcn_mfma_f32_16x16x32_bf16(wf, tf[s], acc, 0, 0, 0); }
            const int c = g * 256 + nt * 16 + 4 * fq;
            const f32x4 sc = scv[k]; const u32x2 gv = gvv[k];
            u32x2 w; w.x = pk2(acc[0] * sc.x * silu(bflo(gv.x)), acc[1] * sc.y * silu(bfhi(gv.x))); w.y = pk2(acc[2] * sc.z * silu(bflo(gv.y)), acc[3] * sc.w * silu(bfhi(gv.y)));
            *(u32x2*)(orow + AW + c) = w;
        }
#pragma unroll
        for (int k = 0; k < CH; ++k) { gvv[k] = gvn[k]; scv[k] = scn[k]; }
    }
}
__device__ __forceinline__ void pool_stage(LAS unsigned char* lds, const bf16_t* WPOOL, int g, int tid) {
    const bf16_t* Wg = WPOOL + (size_t)g * 65536;
    u32x4 wv[16];
#pragma unroll
    for (int k = 0; k < 16; ++k) { const int i = tid + 512 * k; wv[k] = *(const u32x4*)(Wg + (i >> 5) * 256 + (i & 31) * 8); }
#pragma unroll
    for (int k = 0; k < 16; ++k) { const int i = tid + 512 * k; *(LAS u32x4*)(lds + (i >> 5) * 528 + (i & 31) * 16) = wv[k]; }
}
__device__ __forceinline__ void pool_unit(LAS unsigned char* lds, const bf16_t* POOLED, const bf16_t* POOLEDS, const bf16_t* WPOOL, const bf16_t* Z, bf16_t* MIX, const float* pool_scale, int g, int rb, int tid, bool staged) {
    const int lane = tid & 63, wave = tid >> 6, fr = lane & 15, fq = lane >> 4;
    const int row = rb * 128 + wave * 16 + fr;
    bf16x8 tf[8];
    { const bf16_t* arow = POOLED + ((size_t)g * MP + row) * 256 + fq * 8;
#pragma unroll
      for (int s = 0; s < 8; ++s) tf[s] = *(const bf16x8*)(arow + 32 * s); }
    if (!staged) pool_stage(lds, WPOOL, g, tid);
    __syncthreads();
    pool_tile16<4>(lds, tf, Z + (size_t)row * INW, MIX + (size_t)row * DM, pool_scale, g, fr, fq, 0, 4);
    if (rb == 0) {
#pragma unroll 1
        for (int hf = 0; hf < 2; ++hf) { const int srow = hf * 16 + fr; bf16x8 ts[8];
            { const bf16_t* arow = POOLEDS + ((size_t)g * MS + srow) * 256 + fq * 8;
#pragma unroll
              for (int s = 0; s < 8; ++s) ts[s] = *(const bf16x8*)(arow + 32 * s); }
            pool_tile16<2>(lds, ts, Z + (size_t)(MP + srow) * INW, MIX + (size_t)(MP + srow) * DM, pool_scale, g, fr, fq, 2 * wave, 1); }
    }
    __syncthreads();
}

__device__ __forceinline__ void attn_sample_round(LAS unsigned char* lds, const Args& a, const bf16_t* Z, bf16_t* MIX, int task, int tid) {
    const int lane = tid & 63, wave = tid >> 6, q4 = wave & 3, half = wave >> 2;
    LAS float* msh = (LAS float*)(lds + 8192);
    const bool act = task < DB * DT * NH;
    const int h = task & 15, t = (task >> 4) & 3, b = (task >> 6) & 7;
    const size_t zrow = (size_t)(MP + b * DT + t) * INW;
    if (act) {
        const float* ks = a.out + O_KS; const float* vs = a.out + O_VS;
        const int slot = lane >> 4, c4 = lane & 15, e0 = 97 * q4;
        float qv[4];
        { const u32x2 w = *(const u32x2*)(Z + zrow + C_Q + h * HD + 4 * c4); qv[0] = bflo(w.x); qv[1] = bfhi(w.x); qv[2] = bflo(w.y); qv[3] = bfhi(w.y); }
        float sc[25]; float m = -INFINITY;
#pragma unroll
        for (int i = 0; i < 25; ++i) {
            const int el = slot + 4 * i, e = e0 + el; const bool valid = (el < 97) && (e < 387); const int ec = valid ? e : 0;
            const int p = (ec >= 129) + (ec >= 258), j = ec - 129 * p, R = BUF + t - (j << (2 * p));
            const float* kr = (R < BUF) ? a.cache_k + ((size_t)(b * BUF + R) * NH + h) * HD : ks + ((size_t)(b * BUF + R - DT) * NH + h) * HD;
            const f32x4 kv = *(const f32x4*)(kr + 4 * c4);
            float s = (qv[0] * kv.x + qv[1] * kv.y) + (qv[2] * kv.z + qv[3] * kv.w);
            s += __shfl_xor(s, 1); s += __shfl_xor(s, 2); s += __shfl_xor(s, 4); s += __shfl_xor(s, 8);
            s = valid ? s * 0.125f * LOG2E : -INFINITY; sc[i] = s; m = fmaxf(m, s);
        }
        m = fmaxf(m, __shfl_xor(m, 16)); m = fmaxf(m, __shfl_xor(m, 32));
        float l = 0.f;
#pragma unroll
        for (int i = 0; i < 25; ++i) { const float pe = __builtin_amdgcn_exp2f(sc[i] - m); sc[i] = pe; l += pe; }
        l += __shfl_xor(l, 16); l += __shfl_xor(l, 32);
        f32x4 acc = (f32x4){0.f, 0.f, 0.f, 0.f};
#pragma unroll
        for (int i = 0; i < 25; ++i) {
            const int el = slot + 4 * i, e = e0 + el; const bool valid = (el < 97) && (e < 387); const int ec = valid ? e : 0;
            const float pe = sc[i];
            const int p = (ec >= 129) + (ec >= 258), j = ec - 129 * p, R = BUF + t - (j << (2 * p));
            const float* vr = (R < BUF) ? a.cache_v + ((size_t)(b * BUF + R) * NH + h) * HD : vs + ((size_t)(b * BUF + R - DT) * NH + h) * HD;
            const f32x4 vv = *(const f32x4*)(vr + 4 * c4);
            acc.x += pe * vv.x; acc.y += pe * vv.y; acc.z += pe * vv.z; acc.w += pe * vv.w;
        }
        acc.x += __shfl_xor(acc.x, 16); acc.y += __shfl_xor(acc.y, 16); acc.z += __shfl_xor(acc.z, 16); acc.w += __shfl_xor(acc.w, 16);
        acc.x += __shfl_xor(acc.x, 32); acc.y += __shfl_xor(acc.y, 32); acc.z += __shfl_xor(acc.z, 32); acc.w += __shfl_xor(acc.w, 32);
        if (lane < 16) { LAS float* d = msh + wave * 68 + 4 * c4; d[0] = acc.x; d[1] = acc.y; d[2] = acc.z; d[3] = acc.w; }
        if (lane == 0) { msh[wave * 68 + 64] = m; msh[wave * 68 + 65] = l; }
    }
    __syncthreads();
    if (act && q4 == 0 && lane < 16) {
        const LAS float* s0 = msh + (half * 4) * 68;
        const float m0 = s0[64], m1 = s0[68 + 64], m2 = s0[136 + 64], m3 = s0[204 + 64];
        const float M = fmaxf(fmaxf(m0, m1), fmaxf(m2, m3));
        const float w0 = __builtin_amdgcn_exp2f(m0 - M), w1 = __builtin_amdgcn_exp2f(m1 - M), w2 = __builtin_amdgcn_exp2f(m2 - M), w3 = __builtin_amdgcn_exp2f(m3 - M);
        const float L = s0[65] * w0 + s0[68 + 65] * w1 + s0[136 + 65] * w2 + s0[204 + 65] * w3;
        const float inv = 1.f / L;
        float o[4];
#pragma unroll
        for (int k = 0; k < 4; ++k) o[k] = (s0[4 * lane + k] * w0 + s0[68 + 4 * lane + k] * w1 + s0[136 + 4 * lane + k] * w2 + s0[204 + 4 * lane + k] * w3) * inv;
        const u32x2 gv = *(const u32x2*)(Z + zrow + C_GA + h * HD + 4 * lane);
        u32x2 w; w.x = pk2(o[0] * silu(bflo(gv.x)), o[1] * silu(bfhi(gv.x))); w.y = pk2(o[2] * silu(bflo(gv.y)), o[3] * silu(bfhi(gv.y)));
        *(u32x2*)(MIX + (size_t)(MP + b * DT + t) * DM + h * HD + 4 * lane) = w;
    }
    __syncthreads();
}

__global__ void __launch_bounds__(512, 2) hymba_fwd(Args a) {
    extern __shared__ __attribute__((aligned(16))) unsigned char lds_raw[];
    LAS unsigned char* lds = (LAS unsigned char*)lds_raw;
    cg::grid_group grid = cg::this_grid();
    if (a.ws == nullptr) grid.sync();
    if (threadIdx.x < 4) ((volatile LAS unsigned*)(lds + LDS_BYTES - 64))[threadIdx.x] = 0u;
    __syncthreads();
    const XcdBarrier xbar = xcd_barrier_post((unsigned*)(a.ws + WS_BAR), (volatile LAS unsigned*)(lds + LDS_BYTES - 64));
    const int G = gridDim.x, bx = blockIdx.x;
    const int wave0 = __builtin_amdgcn_readfirstlane(threadIdx.x >> 6);
    const int vcu = osgpr((G % 8 == 0) ? (bx % 8) * (G / 8) + bx / 8 : bx);
#define PHASE_IDS const int tid = otid(wave0), lane = tid & 63, wave = wave0; \
    const int gw = osgpr(vcu * 8 + wave), NGW = G * 8, gt = osgpr(vcu * 512) + tid, NGT = G * 512; (void)gw; (void)NGW; (void)gt; (void)NGT; (void)lane;
    unsigned char* ws = a.ws;
    bf16_t* WIN = (bf16_t*)(ws + WS_WIN); bf16_t* WOUT = (bf16_t*)(ws + WS_WOUT); bf16_t* WPOOL = (bf16_t*)(ws + WS_WPOOL);
    bf16_t* XN = (bf16_t*)(ws + WS_XN); bf16_t* Z = (bf16_t*)(ws + WS_Z); bf16_t* MIX = (bf16_t*)(ws + WS_MIX);
    bf16_t* POOLED = (bf16_t*)(ws + WS_POOLED); bf16_t* POOLEDS = (bf16_t*)(ws + WS_POOLEDS);

#if PHM & 1
    for (int rep_ = 0; rep_ < 1 + ((PHDUP >> 0) & 1); ++rep_) {
        PHASE_IDS
        LAS float* scr = (LAS float*)(lds + wave * 16384);
        constexpr int I_IN = (DM / 64) * (INW / 32), I_OUT = (DM / 64) * (DM / 32), I_PL = (256 / 64) * (256 / 32);
        constexpr int NITEMS = I_IN + 4 * I_PL;
        for (int it = gw; it < NITEMS; it += NGW) {
            int r = it;
            if (r < I_IN) { p0_transpose_item(a.w_in, DM, INW, WIN, scr, r, lane); continue; } r -= I_IN;
            const int g = r / I_PL; r -= g * I_PL;
            p0_transpose_item(a.w_pool + (size_t)g * 65536, 256, 256, WPOOL + (size_t)g * 65536, scr, r, lane);
        }
        for (int m = gw; m < MT; m += NGW) {
            const float* xr = (m < MP) ? a.x_prompt + (size_t)m * DM : a.x_sample + (size_t)(m - MP) * DM;
            rms_row_to_bf16(xr, a.norm_g, XN + (size_t)m * DM, lane);
        }
        {
            for (int i0 = CP_ATT + gt; i0 < 2 * CP_N; i0 += 8 * NGT) {
                f32x4 cv[8]; f32x4* cd[8];
#pragma unroll
                for (int u = 0; u < 8; ++u) { const int i = i0 + u * NGT; const f32x4* sp; cp_addr(a, i < 2 * CP_N ? i : CP_ATT, sp, cd[u]); cv[u] = __builtin_nontemporal_load(sp); }
#pragma unroll
                for (int u = 0; u < 8; ++u) if (i0 + u * NGT < 2 * CP_N) __builtin_nontemporal_store(cv[u], cd[u]);
            }
            constexpr int PPER_B = (PH - DT) * PW / 4, NPP = DB * PPER_B;
            f32x4* pd = (f32x4*)(a.out + O_PS); const f32x4* psrc = (const f32x4*)a.state_pool;
            for (int i = gt; i < NPP; i += NGT) { const int b = i / PPER_B, o = i - b * PPER_B;
                pd[(size_t)b * (PH * PW / 4) + o] = psrc[(size_t)b * (PH * PW / 4) + DT * PW / 4 + o]; }
        }
    }
#endif
    GRID_SYNC();

#if PHM & 2
    for (int rep_ = 0; rep_ < 1 + ((PHDUP >> 1) & 1); ++rep_) {
        SEpiZ se{Z, a.out};
        small_gemm(lds, XN + (size_t)MP * DM, WIN, INW / 32, DM, bx, G, se, otid(wave0));
        pg8::Gemm g{XN, WIN, MP, INW, DM}; pg8::StaticOrder S; S.init(MP, INW, G, bx);
        EpiZ E{Z, a.out, (bf16_t*)(ws + WS_KC), (bf16_t*)(ws + WS_VC)};
        pg8::gemm_phase<EpiZ, pg8::StaticOrder, true, true>(lds, g, S, E, otid(wave0));
    }
#endif
    GRID_SYNC();

#if PHM & 4
    for (int rep_ = 0; rep_ < 1 + ((PHDUP >> 2) & 1); ++rep_) {
        PHASE_IDS
        for (int u = vcu; u < NB * NH * 8; u += G) attn_prompt_unit(lds, Z, MIX, u >> 7, (u >> 3) & 15, u & 7, wave0, a, u, (const bf16_t*)(ws + WS_KC), (const bf16_t*)(ws + WS_VC));
        {
            LAS float* scr = (LAS float*)(lds + wave * 16384);
            constexpr int I_OUT2 = (DM / 64) * (DM / 32);
            for (int it = gw; it < I_OUT2; it += NGW) p0_transpose_item(a.w_out, DM, DM, WOUT, scr, it, lane);
            __syncthreads();
        }
        for (int item = gt; item < 4 * (MP / 8) * 32; item += NGT) {
            const int cc = item & 31, rc = (item >> 5) & (MP / 8 - 1), g = item >> 15, row0 = rc * 8, pos0 = row0 & (SEQ - 1);
            const bf16_t* up = Z + C_U + g * 256 + cc * 8; bf16_t* pp = POOLED + ((size_t)g * MP) * 256 + cc * 8;
            if (g == 0) pooled_item<2>(up, pp, row0, pos0); else if (g == 1) pooled_item<4>(up, pp, row0, pos0);
            else if (g == 2) pooled_item<8>(up, pp, row0, pos0); else pooled_item<16>(up, pp, row0, pos0);
        }
        for (int i = gt; i < MS * PW; i += NGT) {
            const int c = i & (PW - 1), rw = i >> 10, b = rw >> 2, t = rw & 3, g = c >> 8, w = 2 << g;
            float s = 0.f, cur = 0.f;
#pragma unroll
            for (int k = 0; k < 16; ++k) if (k < w) { const int e = PH + t - k;
                const float v = (e < PH) ? a.state_pool[((size_t)b * PH + e) * PW + c] : __builtin_bit_cast(float, (unsigned)Z[(size_t)(MP + b * DT + e - PH) * INW + C_U + c] << 16);
                s += v; if (k == 0) cur = v; }
            POOLEDS[((size_t)g * MS + rw) * 256 + (c & 255)] = (bf16_t)f2bf(s / (float)w - cur);
        }
        if (vcu < 256) { __syncthreads(); pool_stage(lds, WPOOL, vcu >> 6, tid); }
    }
#endif
    GRID_SYNC();

#if PHM & 8
    for (int rep_ = 0; rep_ < 1 + ((PHDUP >> 3) & 1); ++rep_) {
        PHASE_IDS
        for (int u = vcu; u < 256; u += G) pool_unit(lds, POOLED, POOLEDS, WPOOL, Z, MIX, a.pool_scale, u >> 6, u & 63, tid, (u == vcu) && (PHDUP == 0));
        for (int pi = vcu; pi < DB * DT * NH / 2; pi += G) attn_sample_round(lds, a, Z, MIX, 2 * pi + (wave >> 2), tid);
    }
#endif
    GRID_SYNC();

#if PHM & 16
    for (int rep_ = 0; rep_ < 1 + ((PHDUP >> 4) & 1); ++rep_) {
        if (bx < DM / 32) sample_out_unit(lds, MIX + (size_t)MP * DM, WOUT, a.x_sample, a.out + O_YS, a.final_g, (float*)(ws + WS_SLOTS) + (size_t)MP * 8, (unsigned*)(ws + WS_CNT) + 64 * 32, bx, otid(wave0));
        pg8::Gemm g{MIX, WOUT, MP, DM, DM}; pg8::StaticOrder S; S.init(MP, DM, G, bx);
        EpiYN E{a.x_prompt, a.out + O_YP, a.final_g, (float*)(ws + WS_SLOTS), (unsigned*)(ws + WS_CNT)};
        pg8::gemm_phase<EpiYN, pg8::StaticOrder, false, true>(lds, g, S, E, otid(wave0));
    }
#endif
}

extern "C" void kernel_launch(void* const* d_in, const int* in_sizes, int n_in, void* d_out, int out_size, void* d_ws, size_t ws_size, hipStream_t stream) {
    static int grid = 0;
    if (grid == 0) {
        int dev = 0, cus = 0, per_cu = 0;
        hipGetDevice(&dev);
        hipDeviceGetAttribute(&cus, hipDeviceAttributeMultiprocessorCount, dev);
        if (hipFuncSetAttribute((const void*)hymba_fwd, hipFuncAttributeMaxDynamicSharedMemorySize, LDS_BYTES) != hipSuccess) { fprintf(stderr, "hipFuncSetAttribute failed\n"); grid = -1; return; }
        if (hipOccupancyMaxActiveBlocksPerMultiprocessor(&per_cu, (const void*)hymba_fwd, 512, LDS_BYTES) != hipSuccess || per_cu < 1) { fprintf(stderr, "occupancy query: %d\n", per_cu); per_cu = 1; }
        (void)hipGetLastError();
        grid = cus;
    }
    if (grid < 0) return;
    if (hipMemsetAsync(d_ws, 0, CTL_ZERO_BYTES, stream) != hipSuccess) { fprintf(stderr, "memset failed\n"); return; }
    Args a{};
    a.x_prompt = (const float*)d_in[0]; a.x_sample = (const float*)d_in[1]; a.cache_k = (const float*)d_in[2]; a.cache_v = (const float*)d_in[3];
    a.state_pool = (const float*)d_in[4]; a.norm_g = (const float*)d_in[5]; a.w_in = (const float*)d_in[6]; a.w_pool = (const float*)d_in[7];
    a.pool_scale = (const float*)d_in[8]; a.w_out = (const float*)d_in[9]; a.final_g = (const float*)d_in[10];
    a.out = (float*)d_out; a.ws = (unsigned char*)d_ws;
    void* args[] = {&a};
    hipError_t e = hipLaunchCooperativeKernel((const void*)hymba_fwd, dim3(grid), dim3(512), args, LDS_BYTES, stream);
    if (e != hipSuccess) fprintf(stderr, "cooperative launch failed: %s (grid %d)\n", hipGetErrorString(e), grid);
}
```

```cpp
#include <hip/hip_runtime.h>
#include <hip/hip_cooperative_groups.h>
#include <cstdio>
#include <cstdint>
namespace cg = cooperative_groups;
#define LAS __attribute__((address_space(3)))
namespace pg8 {
#define PG8_LAS __attribute__((address_space(3)))
typedef unsigned short bf16_t;
typedef short bf16x8 __attribute__((ext_vector_type(8)));
typedef float f32x4 __attribute__((ext_vector_type(4)));
typedef unsigned u32x4 __attribute__((ext_vector_type(4)));
constexpr int BM = 256, BK = 64, HALF = 128, HTB = HALF * BK * 2  , STAGE_BYTES = 8 * HTB, NXCD = 8, WGM = 8;

__host__ __device__ __forceinline__ int lds_byte(int r, int c) { const int st = (r >> 4) * 2 + (c >> 5), rr = r & 15, cc = c & 31, ob = rr * 64 + cc * 2; return st * 1024 + (ob ^ (((ob >> 9) & 1) << 5)); }
__host__ __device__ __forceinline__ void stage_rc(int b, int& R, int& C) { const int st = b / 1024, sb = b % 1024, swz = sb ^ (((sb >> 9) & 1) << 5); R = (st >> 1) * 16 + swz / 64; C = (st & 1) * 32 + (swz % 64) / 2; }
__host__ __device__ __forceinline__ int perm32(int rho) { const int n = rho >> 4, i = rho & 15; return 8 * (i >> 2) + 4 * n + (i & 3); }

struct Unit { int pm, pn; };
struct Gemm { const bf16_t* A; const bf16_t* Bt; int M, N, K; };

struct StaticOrder {
    int nM, nN, nwg, G, c;
    __host__ __device__ void init(int M, int N, int G_, int c_) { nM = M / BM; nN = N / BM; nwg = nM * nN; G = G_; c = c_; }
    __host__ __device__ bool next(int i, Unit& u) const {
        const long L = (long)i * G + c; if (L >= nwg) return false;
        int wgid = (int)L; { const int q = nwg / NXCD, r = nwg % NXCD, xcd = wgid % NXCD, off = wgid / NXCD; wgid = (xcd < r ? xcd * (q + 1) : r * (q + 1) + (xcd - r) * q) + off; }
        const int nig = WGM * nN, gid = wgid / nig, fm = gid * WGM, gsz = (nM - fm) < WGM ? (nM - fm) : WGM;
        u.pm = fm + ((wgid % nig) % gsz); u.pn = (wgid % nig) / gsz; return true;
    }
    __device__ __forceinline__ void a_ready(const Unit&) const {}
    __device__ __forceinline__ void done(const Unit&) const {}
};

__device__ __forceinline__ unsigned cvt_pk_bf16(float lo, float hi) { unsigned r; asm volatile("v_cvt_pk_bf16_f32 %0, %1, %2" : "=v"(r) : "v"(lo), "v"(hi)); return r; }
template <class Epi, class Sched, bool ALIGN_EPI = false, bool SP2 = false>
__device__ __forceinline__ void gemm_phase(PG8_LAS unsigned char* lds, const Gemm g, const Sched& S, const Epi& E, const int tid_in) {
    int tid_ = tid_in; asm volatile("" : "+v"(tid_));
    const int tid = tid_, wid = __builtin_amdgcn_readfirstlane(tid >> 6), lane = tid & 63, wr = wid >> 2, wc = wid & 3, fr = lane & 15, fq = lane >> 4;
    const int K = g.K, nt = K / BK;
    unsigned voffA[2], voffB[2];
#pragma unroll
    for (int i = 0; i < 2; ++i) { int R, C; stage_rc(tid * 16 + i * 8192, R, C); const int Rb = Epi::PERM ? ((R & ~31) + perm32(R & 31)) : R;
        voffA[i] = (unsigned)(R * K + C) * 2u; voffB[i] = (unsigned)(Rb * K + C) * 2u; }
    const size_t kstep = (size_t)(BK * 2);
    const size_t hstep = (size_t)HALF * K * 2;
    const size_t tstep = 2 * hstep;
    const unsigned ldsw = (unsigned)wid * 1024u;
    const int aoff = lds_byte(wr * 64 + fr, fq * 8), boff = lds_byte(wc * 32 + fr, fq * 8);
#define PG8_SA(b, h) (((b) * 2 + (h)) * HTB)
#define PG8_SB(b, h) ((4 + (b) * 2 + (h)) * HTB)
#define PG8_STAGE(bufoff, gbase, voff) do { _Pragma("unroll") for (int _i = 0; _i < 2; ++_i) \
        __builtin_amdgcn_global_load_lds((const unsigned*)((const char*)(gbase) + (voff)[_i]), (PG8_LAS unsigned*)(lds + (bufoff) + ldsw + _i * 8192), 16, 0, 0); } while (0)
#define PG8_LDA(dst, b, h) do { _Pragma("unroll") for (int m = 0; m < 4; ++m) _Pragma("unroll") for (int k = 0; k < 2; ++k) dst[m][k] = *(const PG8_LAS bf16x8*)(lds + PG8_SA(b, h) + aoff + m * 2048 + k * 1024); } while (0)
#define PG8_LDB(dst, b, h) do { _Pragma("unroll") for (int n = 0; n < 2; ++n) _Pragma("unroll") for (int k = 0; k < 2; ++k) dst[n][k] = *(const PG8_LAS bf16x8*)(lds + PG8_SB(b, h) + boff + n * 2048 + k * 1024); } while (0)
#define PG8_MMA(ai, bj, At, Bt) do { __builtin_amdgcn_s_setprio(1); _Pragma("unroll") for (int m = 0; m < 4; ++m) _Pragma("unroll") for (int n = 0; n < 2; ++n) _Pragma("unroll") for (int k = 0; k < 2; ++k) \
        acc[ai][bj][m][n] = __builtin_amdgcn_mfma_f32_16x16x32_bf16(Bt[n][k], At[m][k], acc[ai][bj][m][n], 0, 0, 0); __builtin_amdgcn_s_setprio(0); } while (0)
#define PG8_WAIT_V(n) asm volatile("s_waitcnt vmcnt(" #n ")" ::: "memory")
#define PG8_WAIT_L(n) asm volatile("s_waitcnt lgkmcnt(" #n ")" ::: "memory")
#define PG8_BAR __builtin_amdgcn_s_barrier()
#define PG8_SCHED __builtin_amdgcn_sched_barrier(0)
    Unit cur, nxt; int ui = 0;
    if (!S.next(0, cur)) return;
    f32x4 acc[2][2][4][2];
#pragma unroll
    for (int a = 0; a < 2; ++a)
#pragma unroll
        for (int b = 0; b < 2; ++b)
#pragma unroll
            for (int m = 0; m < 4; ++m)
#pragma unroll
                for (int n = 0; n < 2; ++n) acc[a][b][m][n] = (f32x4){0.f, 0.f, 0.f, 0.f};
    bf16x8 At[4][2], B0[2][2], B1[2][2];
    const char* cA = (const char*)g.A + (size_t)cur.pm * tstep; const char* cB = (const char*)g.Bt + (size_t)cur.pn * tstep;
    S.a_ready(cur);
    if constexpr (SP2) {
        PG8_STAGE(PG8_SB(0, 0), cB, voffB); PG8_STAGE(PG8_SB(0, 1), cB + hstep, voffB); PG8_STAGE(PG8_SA(0, 0), cA, voffA); PG8_STAGE(PG8_SA(0, 1), cA + hstep, voffA);
        if (wr == 1) PG8_BAR;
        PG8_WAIT_V(2); PG8_BAR;
        PG8_STAGE(PG8_SB(1, 0), cB + kstep, voffB); PG8_STAGE(PG8_SA(1, 0), cA + kstep, voffA); PG8_STAGE(PG8_SB(1, 1), cB + hstep + kstep, voffB);
        PG8_WAIT_V(6); PG8_BAR;
    } else {
        PG8_STAGE(PG8_SB(0, 0), cB, voffB); PG8_STAGE(PG8_SA(0, 0), cA, voffA); PG8_STAGE(PG8_SB(0, 1), cB + hstep, voffB); PG8_STAGE(PG8_SA(0, 1), cA + hstep, voffA);
        if (wr == 1) PG8_BAR;
        PG8_WAIT_V(4); PG8_BAR;
        PG8_STAGE(PG8_SB(1, 0), cB + kstep, voffB); PG8_STAGE(PG8_SA(1, 0), cA + kstep, voffA); PG8_STAGE(PG8_SB(1, 1), cB + hstep + kstep, voffB);
        PG8_WAIT_V(6); PG8_BAR;
    }
    for (;;) {
        const bool has_next = S.next(ui + 1, nxt);
        const char* nA = has_next ? (const char*)g.A + (size_t)nxt.pm * tstep : cA; const char* nB = has_next ? (const char*)g.Bt + (size_t)nxt.pn * tstep : cB;
        for (int t = 0; t < nt; t += 2) {
            const bool last = (t == nt - 2);
            const char* a1 = cA + (size_t)(t + 1) * kstep;
            const char* a2 = last ? nA : cA + (size_t)(t + 2) * kstep; const char* b2 = last ? nB : cB + (size_t)(t + 2) * kstep;
            const char* a3 = a2 + kstep; const char* b3 = b2 + kstep;
            if (last && has_next) S.a_ready(nxt);
            if constexpr (SP2) {
            PG8_LDB(B0, 0, 0); PG8_LDB(B1, 0, 1); PG8_SCHED; PG8_LDA(At, 0, 0); PG8_STAGE(PG8_SA(1, 1), a1 + hstep, voffA);
            PG8_WAIT_V(8); PG8_WAIT_L(0); PG8_BAR; PG8_MMA(0, 0, At, B0); PG8_MMA(0, 1, At, B1); PG8_BAR; PG8_SCHED;
            PG8_LDA(At, 0, 1); PG8_STAGE(PG8_SB(0, 0), b2, voffB); PG8_STAGE(PG8_SB(0, 1), b2 + hstep, voffB); PG8_STAGE(PG8_SA(0, 0), a2, voffA);
            PG8_WAIT_V(8); PG8_WAIT_L(0); PG8_BAR; PG8_MMA(1, 0, At, B0); PG8_MMA(1, 1, At, B1); PG8_BAR; PG8_SCHED;
            PG8_LDB(B0, 1, 0); PG8_LDB(B1, 1, 1); PG8_SCHED; PG8_LDA(At, 1, 0); PG8_STAGE(PG8_SA(0, 1), a2 + hstep, voffA);
            PG8_WAIT_V(8); PG8_WAIT_L(0); PG8_BAR; PG8_MMA(0, 0, At, B0); PG8_MMA(0, 1, At, B1); PG8_BAR; PG8_SCHED;
            PG8_LDA(At, 1, 1); PG8_STAGE(PG8_SB(1, 0), b3, voffB); PG8_STAGE(PG8_SB(1, 1), b3 + hstep, voffB); PG8_STAGE(PG8_SA(1, 0), a3, voffA);
            PG8_WAIT_V(8); PG8_WAIT_L(0); PG8_BAR; PG8_MMA(1, 0, At, B0); PG8_MMA(1, 1, At, B1); PG8_BAR; PG8_SCHED;
            } else {
            PG8_LDB(B0, 0, 0); PG8_SCHED; PG8_LDA(At, 0, 0); PG8_STAGE(PG8_SA(1, 1), a1 + hstep, voffA);
            PG8_WAIT_L(8); PG8_BAR; PG8_WAIT_L(0); PG8_MMA(0, 0, At, B0); PG8_BAR; PG8_SCHED;
            PG8_LDB(B1, 0, 1); PG8_STAGE(PG8_SB(0, 0), b2, voffB);
            PG8_BAR; PG8_WAIT_L(0); PG8_MMA(0, 1, At, B1); PG8_BAR;
            PG8_LDA(At, 0, 1); PG8_STAGE(PG8_SA(0, 0), a2, voffA);
            PG8_BAR; PG8_WAIT_L(0); PG8_MMA(1, 0, At, B0); PG8_BAR; PG8_SCHED;
            PG8_STAGE(PG8_SB(0, 1), b2 + hstep, voffB);
            PG8_WAIT_V(6); PG8_BAR; PG8_MMA(1, 1, At, B1); PG8_BAR;
            PG8_LDB(B0, 1, 0); PG8_SCHED; PG8_LDA(At, 1, 0); PG8_STAGE(PG8_SA(0, 1), a2 + hstep, voffA);
            PG8_WAIT_L(8); PG8_BAR; PG8_WAIT_L(0); PG8_MMA(0, 0, At, B0); PG8_BAR; PG8_SCHED;
            PG8_LDB(B1, 1, 1); PG8_STAGE(PG8_SB(1, 0), b3, voffB);
            PG8_BAR; PG8_WAIT_L(0); PG8_MMA(0, 1, At, B1); PG8_BAR;
            PG8_LDA(At, 1, 1); PG8_STAGE(PG8_SA(1, 0), a3, voffA);
            PG8_BAR; PG8_WAIT_L(0); PG8_MMA(1, 0, At, B0); PG8_BAR; PG8_SCHED;
            PG8_STAGE(PG8_SB(1, 1), b3 + hstep, voffB);
            PG8_WAIT_V(6); PG8_BAR; PG8_MMA(1, 1, At, B1); PG8_BAR;
            }
        }
        if constexpr (ALIGN_EPI) { if (wr == 0) PG8_BAR; }
        if constexpr (!Epi::AFTER_DRAIN) { E(acc, cur, wr, wc, fr, fq); S.done(cur); }
        if (!has_next) break;
#pragma unroll
        for (int a = 0; a < 2; ++a)
#pragma unroll
            for (int b = 0; b < 2; ++b)
#pragma unroll
                for (int m = 0; m < 4; ++m)
#pragma unroll
                    for (int n = 0; n < 2; ++n) acc[a][b][m][n] = (f32x4){0.f, 0.f, 0.f, 0.f};
        cur = nxt; cA = nA; cB = nB; ++ui;
        if constexpr (ALIGN_EPI) { if (wr == 1) PG8_BAR; }
    }
    PG8_WAIT_V(0);
    if constexpr (!ALIGN_EPI) { if (wr == 0) PG8_BAR; }
    PG8_BAR;
    if constexpr (Epi::AFTER_DRAIN) { E.fused(acc, cur, wr, wc, fr, fq, lds, wid, lane); S.done(cur); }
#undef PG8_SA
#undef PG8_SB
#undef PG8_STAGE
#undef PG8_LDA
#undef PG8_LDB
#undef PG8_MMA
#undef PG8_WAIT_V
#undef PG8_WAIT_L
#undef PG8_BAR
#undef PG8_SCHED
}
}
#define XB_TMO      128
#define XB_XCNT(j)  (256  + 64 * (j))
#define XB_XSUB(j)  (1280 + 64 * (j))
#define XB_XGEN(j)  (2304 + 64 * (j))
#define XB_TOP      3328
#define XB_TOPGEN   3392
#define XCD_BAR_WORDS 3456
#define XB_SPIN_CAP (1u << 18)

__device__ __forceinline__ unsigned xb_ld(unsigned* p)              { return __hip_atomic_load(p, __ATOMIC_RELAXED, __HIP_MEMORY_SCOPE_AGENT); }
__device__ __forceinline__ unsigned xb_add(unsigned* p, unsigned v) { return __hip_atomic_fetch_add(p, v, __ATOMIC_RELAXED, __HIP_MEMORY_SCOPE_AGENT); }
__device__ __forceinline__ unsigned xb_xcc_id() { return (unsigned)__builtin_amdgcn_s_getreg((3 << 11) | 20) & 0xFu; }
#define XB_SPIN(cond, bar) do { unsigned _sp = 0; while (cond) { __builtin_amdgcn_s_sleep(1); \
    if ((++_sp & 255u) == 0u) { if (xb_ld(&(bar)[XB_TMO])) break; if (_sp > XB_SPIN_CAP) { atomicAdd(&(bar)[XB_TMO], 1u); break; } } } } while (0)

struct XcdBarrier {
    unsigned* bar; unsigned x;
    volatile LAS unsigned* st;
};

__device__ __forceinline__ XcdBarrier xcd_barrier_post(unsigned* bar, volatile LAS unsigned* st) {
    XcdBarrier b; b.bar = bar; b.x = xb_xcc_id(); b.st = st;
    if (threadIdx.x == 0) (void)xb_add(&bar[XB_XCNT(b.x)], 1u);
    return b;
}
__device__ __forceinline__ void xcd_barrier_complete(unsigned* bar, unsigned x, unsigned& nloc, unsigned& nx) {
    const unsigned G = gridDim.x * gridDim.y * gridDim.z;
    unsigned sum, cnt, mine, sp = 0u;
    for (;;) {
        sum = 0u; cnt = 0u; mine = 0u;
#pragma unroll
        for (unsigned j = 0; j < 16; ++j) { const unsigned c = xb_ld(&bar[XB_XCNT(j)]); sum += c; cnt += (c > 0u) ? 1u : 0u; mine = (j == x) ? c : mine; }
        if (sum == G) break;
        __builtin_amdgcn_s_sleep(1);
        if ((++sp & 255u) == 0u) { if (xb_ld(&bar[XB_TMO])) break; if (sp > XB_SPIN_CAP) { atomicAdd(&bar[XB_TMO], 1u); break; } }
    }
    nloc = mine > 0u ? mine : 1u; nx = cnt > 0u ? cnt : 1u;
}

__device__ __forceinline__ void xcd_barrier(const XcdBarrier& b) {
    asm volatile("s_waitcnt vmcnt(0)" ::: "memory");
    __syncthreads();
    if (threadIdx.x == 0) {
        unsigned* bar = b.bar;
        __builtin_amdgcn_s_waitcnt(0);
        unsigned nloc = b.st[0], nx = b.st[1];
        if (nloc == 0u) { xcd_barrier_complete(bar, b.x, nloc, nx); b.st[0] = nloc; b.st[1] = nx; }
        const unsigned old = xb_add(&bar[XB_XSUB(b.x)], 1u);
        const unsigned gen = old / nloc;
        if (old + 1u == (gen + 1u) * nloc) {
            __builtin_amdgcn_fence(__ATOMIC_RELEASE, "agent");
            asm volatile("s_waitcnt vmcnt(0)" ::: "memory");
            const unsigned og = xb_add(&bar[XB_TOP], 1u);
            const unsigned tg = og / nx;
            if (og + 1u == (tg + 1u) * nx) xb_add(&bar[XB_TOPGEN], 1u);
            else XB_SPIN(xb_ld(&bar[XB_TOPGEN]) == tg, bar);
            __builtin_amdgcn_fence(__ATOMIC_ACQUIRE, "agent");
            xb_add(&bar[XB_XGEN(b.x)], 1u);
            asm volatile("s_waitcnt vmcnt(0)" ::: "memory");
        } else {
            XB_SPIN(xb_ld(&bar[XB_XGEN(b.x)]) == gen, bar);
            __builtin_amdgcn_fence(__ATOMIC_ACQUIRE, "agent");
            asm volatile("s_waitcnt vmcnt(0)" ::: "memory");
        }
    }
    __syncthreads();
}

typedef unsigned short bf16_t;
typedef short bf16x8 __attribute__((ext_vector_type(8)));
typedef float f32x4 __attribute__((ext_vector_type(4)));
typedef float f32x16 __attribute__((ext_vector_type(16)));
typedef unsigned u32x4 __attribute__((ext_vector_type(4)));
typedef unsigned u32x2 __attribute__((ext_vector_type(2)));

constexpr int DM = 2048, SEQ = 4096, NB = 2, MP = NB * SEQ  , MS = 32  , MT = MP + MS;
constexpr int INW = 6144, AW = 1024, NH = 16, HD = 64, BUF = 2048, DB = 8, DT = 4, PH = 15, PW = 1024;
constexpr int C_Q = 0, C_K = 1024, C_V = 2048, C_GA = 3072, C_U = 4096, C_GP = 5120;
constexpr float EPS = 1e-6f;
constexpr float LOG2E = 1.4426950408889634f;

constexpr size_t O_YP = 0, O_YS = 16777216, O_KP = 16842752, O_VP = 21037056, O_PP = 25231360, O_KS = 25262080, O_VS = 42039296, O_PS = 58816512;

constexpr size_t MiB = 1u << 20;
constexpr size_t WS_CNT = 0  , WS_BAR = 65536, CTL_ZERO_BYTES = 131072, WS_SLOTS = 1 * MiB  , WS_WIN = 2 * MiB, WS_WOUT = 26 * MiB, WS_WPOOL = 34 * MiB, WS_XN = 36 * MiB, WS_Z = 70 * MiB, WS_MIX = 168 * MiB,
                 WS_POOLED = 202 * MiB, WS_POOLEDS = 219 * MiB, WS_KC = 220 * MiB, WS_VC = 238 * MiB;

constexpr int LDS_BYTES = 155648;
#ifndef PHM
#define PHM 63
#endif
#ifndef PHDUP
#define PHDUP 0
#endif
#ifndef SYNCDUP
#define SYNCDUP 1
#endif
#define GRID_SYNC() do { for (int s_ = 0; s_ < SYNCDUP; ++s_) xcd_barrier(xbar); } while (0)

struct Args {
    const float* x_prompt; const float* x_sample; const float* cache_k; const float* cache_v; const float* state_pool;
    const float* norm_g; const float* w_in; const float* w_pool; const float* pool_scale; const float* w_out; const float* final_g;
    float* out; unsigned char* ws;
};

__device__ __forceinline__ int otid(int wave_s) { int l; asm volatile("v_mbcnt_lo_u32_b32 %0, -1, 0\n\tv_mbcnt_hi_u32_b32 %0, -1, %0" : "=v"(l)); return wave_s * 64 + l; }
__device__ __forceinline__ int osgpr(int v) { asm volatile("" : "+s"(v)); return v; }
__device__ __forceinline__ unsigned f2bf(float f) { unsigned u = __builtin_bit_cast(unsigned, f); return (u + 0x7fffu + ((u >> 16) & 1u)) >> 16; }
typedef float f32x2_t __attribute__((ext_vector_type(2))); typedef __bf16 bf16x2_t __attribute__((ext_vector_type(2)));
__device__ __forceinline__ unsigned pk2(float lo, float hi) { f32x2_t v = {lo, hi}; bf16x2_t b = __builtin_convertvector(v, bf16x2_t); return __builtin_bit_cast(unsigned, b); }
__device__ __forceinline__ float bflo(unsigned w) { return __builtin_bit_cast(float, w << 16); }
__device__ __forceinline__ float bfhi(unsigned w) { return __builtin_bit_cast(float, w & 0xffff0000u); }
__device__ __forceinline__ float silu(float v) { return v * __builtin_amdgcn_rcpf(1.f + __builtin_amdgcn_exp2f(-1.4426950408889634f * v)); }
__device__ __forceinline__ float wave_sum(float v) {
#pragma unroll
    for (int o = 1; o < 64; o <<= 1) v += __shfl_xor(v, o);
    return v;
}
__device__ __forceinline__ float wave_max(float v) {
#pragma unroll
    for (int o = 1; o < 64; o <<= 1) v = fmaxf(v, __shfl_xor(v, o));
    return v;
}

__device__ __forceinline__ void p0_transpose_item(const float* W, int K, int N, bf16_t* WT, LAS float* scr, int item, int lane) {
    const int nblk = N / 32, kb = item / nblk, nb = item % nblk, k0 = 64 * kb, n0 = 32 * nb;
    f32x4 v[8];
#pragma unroll
    for (int i = 0; i < 8; ++i) v[i] = __builtin_nontemporal_load((const f32x4*)(W + (size_t)(k0 + 8 * i + (lane >> 3)) * N + n0 + 4 * (lane & 7)));
#pragma unroll
    for (int i = 0; i < 8; ++i) { LAS float* d = scr + (8 * i + (lane >> 3)) * 33 + 4 * (lane & 7); d[0] = v[i].x; d[1] = v[i].y; d[2] = v[i].z; d[3] = v[i].w; }
    asm volatile("s_waitcnt lgkmcnt(0)" ::: "memory");
    const int c = lane & 7;
#pragma unroll
    for (int j = 0; j < 4; ++j) { const int n = (lane >> 3) + 8 * j; const LAS float* s = scr + (8 * c) * 33 + n;
        u32x4 o; o.x = pk2(s[0 * 33], s[1 * 33]); o.y = pk2(s[2 * 33], s[3 * 33]); o.z = pk2(s[4 * 33], s[5 * 33]); o.w = pk2(s[6 * 33], s[7 * 33]);
        *(u32x4*)(WT + (size_t)(n0 + n) * K + k0 + 8 * c) = o; }
    asm volatile("s_waitcnt lgkmcnt(0)" ::: "memory");
}

__device__ __forceinline__ void rms_row_to_bf16(const float* xrow, const float* g, bf16_t* orow, int lane) {
    const f32x4* xr = (const f32x4*)xrow + lane; const f32x4* gr = (const f32x4*)g + lane;
    f32x4 v[8]; float s = 0.f;
#pragma unroll
    for (int j = 0; j < 8; ++j) { v[j] = __builtin_nontemporal_load(xr + 64 * j); s += (v[j].x * v[j].x + v[j].y * v[j].y) + (v[j].z * v[j].z + v[j].w * v[j].w); }
    const float rs = 1.f / sqrtf(wave_sum(s) * (1.f / DM) + EPS);
    u32x2* o8 = (u32x2*)orow + lane;
#pragma unroll
    for (int j = 0; j < 8; ++j) { const f32x4 gg = gr[64 * j]; u32x2 w; w.x = pk2(v[j].x * rs * gg.x, v[j].y * rs * gg.y); w.y = pk2(v[j].z * rs * gg.z, v[j].w * rs * gg.w); o8[64 * j] = w; }
}

struct EpiZ {
    static constexpr bool PERM = true, AFTER_DRAIN = false;
    bf16_t* Z; float* out; bf16_t* KC; bf16_t* VC;
    __device__ __forceinline__ void operator()(const pg8::f32x4 (&acc)[2][2][4][2], const pg8::Unit& u, int wr, int wc, int fr_, int fq_) const {
        int l_ = (fq_ << 4) | fr_; asm volatile("" : "+v"(l_)); const int fr = l_ & 15, fq = l_ >> 4;
        const int row0 = u.pm * 256 + wr * 64 + fr, col0 = u.pn * 256 + wc * 32 + 8 * fq;
        const int b = u.pm >> 4, pt = u.pm & 15;
        float* fo = nullptr;
        if (pt >= 8) { if (u.pn >= 4 && u.pn < 8) fo = out + O_KP + (col0 - C_K); else if (u.pn >= 8 && u.pn < 12) fo = out + O_VP + (col0 - C_V); }
        const bool pool = (pt == 15) && (u.pn >= 16) && (u.pn < 20);
        bf16_t* cz = nullptr; int ck0 = 0;
        if (u.pn >= 4 && u.pn < 8) { cz = KC; ck0 = col0 - C_K; } else if (u.pn >= 8 && u.pn < 12) { cz = VC; ck0 = col0 - C_V; }
#pragma unroll
        for (int ai = 0; ai < 2; ++ai)
#pragma unroll
            for (int m = 0; m < 4; ++m) {
                const int row = row0 + ai * 128 + m * 16; const int pos = row & (SEQ - 1);
                bf16_t* rowp = Z + (size_t)row * INW + col0;
#pragma unroll
                for (int bj = 0; bj < 2; ++bj) {
                    const pg8::f32x4 v0 = acc[ai][bj][m][0], v1 = acc[ai][bj][m][1];
                    u32x4 w; w.x = pk2(v0[0], v0[1]); w.y = pk2(v0[2], v0[3]); w.z = pk2(v1[0], v1[1]); w.w = pk2(v1[2], v1[3]);
                    if (cz) { const int ck = ck0 + bj * 128; *(u32x4*)(cz + (((size_t)(b * NH + (ck >> 6)) * SEQ + pos) * HD + (ck & 63))) = w; }
                    else *(u32x4*)(rowp + bj * 128) = w;
                    if (fo) { float* p = fo + (size_t)(b * BUF + pos - BUF) * AW + bj * 128; *(pg8::f32x4*)p = v0; *(pg8::f32x4*)(p + 4) = v1; }
                    if (pool && pos >= SEQ - PH) { float* p = out + O_PP + (size_t)(b * PH + pos - (SEQ - PH)) * PW + (col0 - C_U) + bj * 128; *(pg8::f32x4*)p = v0; *(pg8::f32x4*)(p + 4) = v1; }
                }
            }
    }
};

#define NORM_SPIN_CAP (1u << 22)
struct EpiYN {
    static constexpr bool PERM = false, AFTER_DRAIN = true;
    const float* x; float* y; const float* gfin; float* slots; unsigned* cnt;
    __device__ __forceinline__ void fused(pg8::f32x4 (&acc)[2][2][4][2], const pg8::Unit& u, int wr, int wc, int fr, int fq, LAS unsigned char* lds, int wid, int lane) const {
        LAS float* P = (LAS float*)lds;
        LAS float* S = (LAS float*)(lds + 4096);
        const int row0 = u.pm * 256 + wr * 64 + fr, col0 = u.pn * 256 + wc * 32 + 4 * fq;
#pragma unroll
        for (int ai = 0; ai < 2; ++ai)
#pragma unroll
            for (int m = 0; m < 4; ++m) {
                const int row = row0 + ai * 128 + m * 16; float ss = 0.f;
#pragma unroll
                for (int bj = 0; bj < 2; ++bj)
#pragma unroll
                    for (int n = 0; n < 2; ++n) {
                        const f32x4 xv = __builtin_nontemporal_load((const f32x4*)(x + (size_t)row * DM + col0 + bj * 128 + n * 16));
                        pg8::f32x4 hv = acc[ai][bj][m][n]; hv[0] += xv.x; hv[1] += xv.y; hv[2] += xv.z; hv[3] += xv.w; acc[ai][bj][m][n] = hv;
                        ss += (hv[0] * hv[0] + hv[1] * hv[1]) + (hv[2] * hv[2] + hv[3] * hv[3]);
                    }
                ss += __shfl_xor(ss, 16); ss += __shfl_xor(ss, 32);
                if (fq == 0) P[(ai * 128 + wr * 64 + m * 16 + fr) * 4 + wc] = ss;
                if (m & 1) asm volatile("" ::: "memory");
            }
        asm volatile("s_waitcnt lgkmcnt(0)" ::: "memory"); __builtin_amdgcn_s_barrier(); asm volatile("" ::: "memory");
        const int t = wid * 64 + lane;
        if (t < 256) { const float s = (P[t * 4] + P[t * 4 + 1]) + (P[t * 4 + 2] + P[t * 4 + 3]);
            __hip_atomic_store(slots + (size_t)(u.pm * 256 + t) * 8 + u.pn, s, __ATOMIC_RELAXED, __HIP_MEMORY_SCOPE_AGENT); }
        asm volatile("s_waitcnt vmcnt(0)" ::: "memory");
        if (t < 256 && lane == 0) __hip_atomic_fetch_add(cnt + 64 * u.pm, 1u, __ATOMIC_RELAXED, __HIP_MEMORY_SCOPE_AGENT);
        if (wid == 0) { unsigned sp = 0;
            while ((unsigned)__builtin_amdgcn_readfirstlane(__hip_atomic_load(cnt + 64 * u.pm, __ATOMIC_RELAXED, __HIP_MEMORY_SCOPE_AGENT)) < 32u) { __builtin_amdgcn_s_sleep(2); if (++sp > NORM_SPIN_CAP) break; }
            __builtin_amdgcn_fence(__ATOMIC_ACQUIRE, "agent"); }
        asm volatile("s_waitcnt vmcnt(0) lgkmcnt(0)" ::: "memory"); __builtin_amdgcn_s_barrier(); asm volatile("" ::: "memory");
        if (t < 256) { const float* sl = slots + (size_t)(u.pm * 256 + t) * 8; float tot = 0.f;
#pragma unroll
            for (int k = 0; k < 8; ++k) tot += __hip_atomic_load(sl + k, __ATOMIC_RELAXED, __HIP_MEMORY_SCOPE_AGENT);
            S[t] = 1.f / sqrtf(tot * (1.f / DM) + EPS); }
        asm volatile("s_waitcnt vmcnt(0) lgkmcnt(0)" ::: "memory"); __builtin_amdgcn_s_barrier(); asm volatile("" ::: "memory");
        f32x4 gg[2][2];
#pragma unroll
        for (int bj = 0; bj < 2; ++bj)
#pragma unroll
            for (int n = 0; n < 2; ++n) gg[bj][n] = *(const f32x4*)(gfin + col0 + bj * 128 + n * 16);
#pragma unroll
        for (int ai = 0; ai < 2; ++ai)
#pragma unroll
            for (int m = 0; m < 4; ++m) {
                const int rl = ai * 128 + wr * 64 + m * 16 + fr; const float rs = S[rl]; const int row = u.pm * 256 + rl;
#pragma unroll
                for (int bj = 0; bj < 2; ++bj)
#pragma unroll
                    for (int n = 0; n < 2; ++n) { const pg8::f32x4 hv = acc[ai][bj][m][n]; f32x4 o; o.x = hv[0] * rs * gg[bj][n].x; o.y = hv[1] * rs * gg[bj][n].y; o.z = hv[2] * rs * gg[bj][n].z; o.w = hv[3] * rs * gg[bj][n].w;
                        *(f32x4*)(y + (size_t)row * DM + col0 + bj * 128 + n * 16) = o; }
            }
    }
};

template <class Epi>
__device__ __forceinline__ void small_gemm(LAS unsigned char* lds, const bf16_t* A, const bf16_t* Bt, int ntiles, int K, int tile0, int tstride, const Epi& E, const int tid) {
    const int  wid = tid >> 6, lane = tid & 63, fr = lane & 15, fq = lane >> 4;
    LAS float* red = (LAS float*)lds;
    const int kw = K >> 3, k0 = wid * kw;
    for (int tile = tile0; tile < ntiles; tile += tstride) {
        const int n0 = tile * 32;
        f32x4 acc[2][2];
#pragma unroll
        for (int a = 0; a < 2; ++a)
#pragma unroll
            for (int b = 0; b < 2; ++b) acc[a][b] = (f32x4){0.f, 0.f, 0.f, 0.f};
        const bf16_t* ap = A + (size_t)fr * K + k0 + fq * 8;
        const bf16_t* bp = Bt + (size_t)(n0 + fr) * K + k0 + fq * 8;
#pragma unroll 4
        for (int kk = 0; kk < kw; kk += 32) {
            const bf16x8 a0 = *(const bf16x8*)(ap + kk), a1 = *(const bf16x8*)(ap + (size_t)16 * K + kk);
            const bf16x8 b0 = *(const bf16x8*)(bp + kk), b1 = *(const bf16x8*)(bp + (size_t)16 * K + kk);
            acc[0][0] = __builtin_amdgcn_mfma_f32_16x16x32_bf16(a0, b0, acc[0][0], 0, 0, 0);
            acc[0][1] = __builtin_amdgcn_mfma_f32_16x16x32_bf16(a0, b1, acc[0][1], 0, 0, 0);
            acc[1][0] = __builtin_amdgcn_mfma_f32_16x16x32_bf16(a1, b0, acc[1][0], 0, 0, 0);
            acc[1][1] = __builtin_amdgcn_mfma_f32_16x16x32_bf16(a1, b1, acc[1][1], 0, 0, 0);
        }
#pragma unroll
        for (int mi = 0; mi < 2; ++mi)
#pragma unroll
            for (int ni = 0; ni < 2; ++ni)
#pragma unroll
                for (int j = 0; j < 4; ++j) red[wid * 1024 + (mi * 16 + fq * 4 + j) * 32 + ni * 16 + fr] = acc[mi][ni][j];
        __syncthreads();
#pragma unroll
        for (int k = 0; k < 2; ++k) { const int e = tid + 512 * k; float s = 0.f;
#pragma unroll
            for (int w = 0; w < 8; ++w) s += red[w * 1024 + e];
            E(e >> 5, n0 + (e & 31), s); }
        __syncthreads();
    }
}
struct SEpiZ {
    bf16_t* Z; float* out;
    __device__ __forceinline__ void operator()(int row, int col, float v) const {
        Z[(size_t)(MP + row) * INW + col] = (bf16_t)f2bf(v);
        const int b = row >> 2, t = row & 3;
        if (col >= C_K && col < C_V) out[O_KS + (size_t)(b * BUF + BUF - DT + t) * AW + (col - C_K)] = v;
        else if (col >= C_V && col < C_GA) out[O_VS + (size_t)(b * BUF + BUF - DT + t) * AW + (col - C_V)] = v;
        else if (col >= C_U && col < C_GP) out[O_PS + (size_t)(b * PH + PH - DT + t) * PW + (col - C_U)] = v;
    }
};
__device__ __forceinline__ void sample_out_unit(LAS unsigned char* lds, const bf16_t* A, const bf16_t* Bt, const float* xs, float* ys, const float* gfin, float* slots, unsigned* cnt, int tile, int tid) {
    const int wid = tid >> 6, lane = tid & 63, fr = lane & 15, fq = lane >> 4;
    LAS float* red = (LAS float*)lds;
    LAS float* S = (LAS float*)(lds + 32768);
    constexpr int K = DM; const int kw = K >> 3, k0 = wid * kw, n0 = tile * 32;
    f32x4 acc[2][2];
#pragma unroll
    for (int a = 0; a < 2; ++a)
#pragma unroll
        for (int b = 0; b < 2; ++b) acc[a][b] = (f32x4){0.f, 0.f, 0.f, 0.f};
    const bf16_t* ap = A + (size_t)fr * K + k0 + fq * 8;
    const bf16_t* bp = Bt + (size_t)(n0 + fr) * K + k0 + fq * 8;
#pragma unroll 4
    for (int kk = 0; kk < kw; kk += 32) {
        const bf16x8 a0 = *(const bf16x8*)(ap + kk), a1 = *(const bf16x8*)(ap + (size_t)16 * K + kk);
        const bf16x8 b0 = *(const bf16x8*)(bp + kk), b1 = *(const bf16x8*)(bp + (size_t)16 * K + kk);
        acc[0][0] = __builtin_amdgcn_mfma_f32_16x16x32_bf16(a0, b0, acc[0][0], 0, 0, 0);
        acc[0][1] = __builtin_amdgcn_mfma_f32_16x16x32_bf16(a0, b1, acc[0][1], 0, 0, 0);
        acc[1][0] = __builtin_amdgcn_mfma_f32_16x16x32_bf16(a1, b0, acc[1][0], 0, 0, 0);
        acc[1][1] = __builtin_amdgcn_mfma_f32_16x16x32_bf16(a1, b1, acc[1][1], 0, 0, 0);
    }
#pragma unroll
    for (int mi = 0; mi < 2; ++mi)
#pragma unroll
        for (int ni = 0; ni < 2; ++ni)
#pragma unroll
            for (int j = 0; j < 4; ++j) red[wid * 1024 + (mi * 16 + fq * 4 + j) * 32 + ni * 16 + fr] = acc[mi][ni][j];
    __syncthreads();
    float hv[2];
#pragma unroll
    for (int k = 0; k < 2; ++k) { const int e = tid + 512 * k, row = e >> 5, col = n0 + (e & 31); float s = 0.f;
#pragma unroll
        for (int w = 0; w < 8; ++w) s += red[w * 1024 + e];
        const float h = xs[(size_t)row * DM + col] + s; hv[k] = h;
        float ss = h * h;
#pragma unroll
        for (int o = 1; o < 32; o <<= 1) ss += __shfl_xor(ss, o);
        if ((lane & 31) == 0) __hip_atomic_store(slots + row * 64 + tile, ss, __ATOMIC_RELAXED, __HIP_MEMORY_SCOPE_AGENT); }
    asm volatile("s_waitcnt vmcnt(0)" ::: "memory");
    __syncthreads();
    if (tid == 0) { __hip_atomic_fetch_add(cnt, 1u, __ATOMIC_RELAXED, __HIP_MEMORY_SCOPE_AGENT); }
    if (wid == 0) { unsigned sp = 0;
        while ((unsigned)__builtin_amdgcn_readfirstlane(__hip_atomic_load(cnt, __ATOMIC_RELAXED, __HIP_MEMORY_SCOPE_AGENT)) < 64u) { __builtin_amdgcn_s_sleep(2); if (++sp > NORM_SPIN_CAP) break; }
        __builtin_amdgcn_fence(__ATOMIC_ACQUIRE, "agent");
        if (lane < 32) { float tot = 0.f;
#pragma unroll 8
            for (int k = 0; k < 64; ++k) tot += __hip_atomic_load(slots + lane * 64 + k, __ATOMIC_RELAXED, __HIP_MEMORY_SCOPE_AGENT);
            S[lane] = 1.f / sqrtf(tot * (1.f / DM) + EPS); } }
    __syncthreads();
#pragma unroll
    for (int k = 0; k < 2; ++k) { const int e = tid + 512 * k, row = e >> 5, col = n0 + (e & 31);
        ys[(size_t)row * DM + col] = hv[k] * S[row] * gfin[col]; }
    __syncthreads();
}

constexpr int CP_PER_B = (BUF - DT) * AW / 4, CP_N = DB * CP_PER_B, CP_ATT = 256 * 8 * 6 * 512  ;
__device__ __forceinline__ void cp_addr(const Args& a, int i, const f32x4*& src, f32x4*& dst) {
    const bool isv = i >= CP_N; const int ii = isv ? i - CP_N : i; const int b = ii / CP_PER_B, o = ii - b * CP_PER_B;
    const size_t d = (size_t)b * (BUF * AW / 4) + o;
    src = (const f32x4*)(isv ? a.cache_v : a.cache_k) + d + DT * AW / 4;
    dst = (f32x4*)(a.out + (isv ? O_VS : O_KS)) + d;
}

typedef short s16x4 __attribute__((ext_vector_type(4)));
__device__ __forceinline__ s16x4 vtr(const LAS unsigned char* p) { return __builtin_bit_cast(s16x4, __builtin_amdgcn_ds_read_tr16_b64_v4i16((LAS s16x4*)p)); }
__device__ __forceinline__ int crow(int r, int hi) { return (r & 3) + 8 * (r >> 2) + 4 * hi; }
constexpr int OSH_STRIDE = 144, OSH_BYTES = 512 * OSH_STRIDE  , LSH_OFF = OSH_BYTES, VSH_OFF = LSH_OFF + 2048, VSH_WAVE = 32 * 144  ;
constexpr int KSH2_OFF = VSH_OFF + 8 * VSH_WAVE  ;
static_assert(KSH2_OFF + 8 * VSH_WAVE <= LDS_BYTES - 64, "attention LDS map");

__device__ __forceinline__ void attn_prompt_unit(LAS unsigned char* lds, const bf16_t* Z, bf16_t* MIX, int b, int h, int blk, const int wid  , const Args& a, const int unit, const bf16_t* KC, const bf16_t* VC) {
    LAS unsigned char* Osh = lds;
    LAS float* Lsh = (LAS float*)(lds + LSH_OFF);
    LAS unsigned char* Vsh = lds + VSH_OFF + wid * VSH_WAVE;
    const int t0 = blk * 512; const size_t rowbase = (size_t)b * SEQ;
    const char* Kb = (const char*)KC + (size_t)(b * NH + h) * SEQ * (HD * 2); const char* Vb = (const char*)VC + (size_t)(b * NH + h) * SEQ * (HD * 2);
    const float SC = 0.125f * LOG2E;
#pragma unroll 1
    for (int p = 0; p < 3; ++p) {
        const int dil = 1 << (2 * p);
#pragma unroll 1
        for (int gi = 0; gi < 2; ++gi) {
            const int g = wid * 2 + gi;
            const int lane = otid(0); const int r = lane & 31, hh = lane >> 5;
            const int cpbase = (((unit * 8 + wid) * 6) + (p * 2 + gi)) * 512; f32x4 cpv[4]; unsigned cpo[4];
            const bool cp_isv = cpbase >= CP_N; const int cp_ii0 = cp_isv ? cpbase - CP_N : cpbase, cp_vb0 = cp_ii0 / CP_PER_B, cp_next = (cp_vb0 + 1) * CP_PER_B;
            const char* cp_src = (const char*)(cp_isv ? a.cache_v : a.cache_k) + (size_t)DT * AW * 4; char* cp_dst = (char*)(a.out + (cp_isv ? O_VS : O_KS));
#define CP_OFF(K_) ({ const int ii_ = cp_ii0 + (K_) + lane; (unsigned)(ii_ + (ii_ >= cp_next ? cp_vb0 + 1 : cp_vb0) * 1024) * 16u; })
            const char* Zb = (const char*)Z; constexpr unsigned ROWB = INW * 2; const unsigned rb0 = (unsigned)rowbase;
            const LAS unsigned char* vtb = Vsh + (4 * hh + ((lane & 15) >> 2)) * 144 + (16 * ((lane >> 4) & 1) + 4 * (lane & 3)) * 2;
            const int qbase = t0 + (g & (dil - 1)) + dil * 32 * (g >> (2 * p));
            const int qpos = qbase + dil * r;
            const unsigned qoff = (rb0 + (unsigned)qpos) * ROWB + (unsigned)((C_Q + h * HD + hh * 8) * 2);
            bf16x8 bq[4];
#pragma unroll
            for (int s = 0; s < 4; ++s) bq[s] = *(const bf16x8*)(Zb + (size_t)qoff + 32 * s);
            f32x16 X[5];
            {
                u32x4 kr[5][4];
                const int ka0 = qbase + dil * ((lane >> 3) - 128);
                const unsigned kcolb = (unsigned)((C_K + h * HD + (lane & 7) * 8) * 2);
#pragma unroll
                for (int T = 0; T < 5; ++T)
#pragma unroll
                    for (int c = 0; c < 4; ++c) { const int kpos = ka0 + (32 * T + 8 * c) * dil;
                        kr[T][c] = *(const u32x4*)(Kb + (size_t)((unsigned)(kpos < 0 ? 0 : kpos) * 128u + (unsigned)((lane & 7) * 16))); }
#pragma unroll
                for (int u = 0; u < 4; ++u) { cpo[u] = CP_OFF(64 * u); cpv[u] = __builtin_nontemporal_load((const f32x4*)(cp_src + (size_t)cpo[u])); }
                __builtin_amdgcn_sched_barrier(0);
                LAS unsigned char* Ksh2 = lds + KSH2_OFF + wid * VSH_WAVE;
#pragma unroll
                for (int T = 0; T < 5; ++T) {
                    LAS unsigned char* kb = (T & 1) ? Ksh2 : Vsh;
#pragma unroll
                    for (int c = 0; c < 4; ++c) *(LAS u32x4*)(kb + ((lane >> 3) + 8 * c) * 144 + (lane & 7) * 16) = kr[T][c];
                    f32x16 x;
#pragma unroll
                    for (int i = 0; i < 16; ++i) x[i] = 0.f;
#pragma unroll
                    for (int s = 0; s < 4; ++s) { const bf16x8 ka = *(const LAS bf16x8*)(kb + r * 144 + 32 * s + 16 * hh);
                        x = __builtin_amdgcn_mfma_f32_32x32x16_bf16(ka, bq[s], x, 0, 0, 0); }
                    X[T] = x;
                }
                __builtin_amdgcn_sched_barrier(0);
            }
            u32x4 vf[5][4];
            const int va0 = qbase + dil * ((lane >> 3) - 128); const unsigned vcolb = (unsigned)((C_V + h * HD + (lane & 7) * 8) * 2);
#pragma unroll
            for (int T = 0; T < 3; ++T)
#pragma unroll
                for (int c = 0; c < 4; ++c) { const int kposn = va0 + (32 * T + 8 * c) * dil;
                    vf[T][c] = *(const u32x4*)(Vb + (size_t)((unsigned)(kposn < 0 ? 0 : kposn) * 128u + (unsigned)((lane & 7) * 16))); }
#pragma unroll
            for (int u = 0; u < 4; ++u) __builtin_nontemporal_store(cpv[u], (f32x4*)(cp_dst + (size_t)cpo[u]));
#pragma unroll
            for (int u = 0; u < 4; ++u) { cpo[u] = CP_OFF(256 + 64 * u); cpv[u] = __builtin_nontemporal_load((const f32x4*)(cp_src + (size_t)cpo[u])); }
            __builtin_amdgcn_sched_barrier(0);
            const int nneg = 128 - (qbase >> (2 * p));
            const int nlo = (r > nneg ? r : nneg) - 4 * hh, nhi = r + 128 - 4 * hh;
            const int tneg = (nneg > 0) ? ((nneg - 1) >> 5) : -1;
            float mraw = -INFINITY;
#pragma unroll
            for (int T = 0; T < 5; ++T) {
                if (T == 0 || T == 4 || T <= tneg) {
#pragma unroll
                    for (int i = 0; i < 16; ++i) {
                        const int nc = 32 * T + (i & 3) + 8 * (i >> 2);
                        const bool valid = (T == 4 ? nc <= nhi : true) && (T < 4 ? nc >= nlo : true);
                        const float v = valid ? X[T][i] : -INFINITY; X[T][i] = v; mraw = fmaxf(mraw, v);
                    }
                } else {
#pragma unroll
                    for (int i = 0; i < 16; ++i) mraw = fmaxf(mraw, X[T][i]);
                }
            }
            { auto rr = __builtin_amdgcn_permlane32_swap(__float_as_uint(mraw), __float_as_uint(mraw), false, false); mraw = fmaxf(__uint_as_float(rr[0]), __uint_as_float(rr[1])); }
            const float m = mraw * SC, negm = -m;
            float l = 0.f;
#pragma unroll
            for (int T = 0; T < 5; ++T)
#pragma unroll
                for (int i = 0; i < 16; ++i) { const float pe = __builtin_amdgcn_exp2f(__builtin_fmaf(X[T][i], SC, negm)); X[T][i] = pe; l += pe; }
            { auto rr = __builtin_amdgcn_permlane32_swap(__float_as_uint(l), __float_as_uint(l), false, false); l = __uint_as_float(rr[0]) + __uint_as_float(rr[1]); }
            __builtin_amdgcn_sched_barrier(0);
            f32x16 o0, o1;
#pragma unroll
            for (int i = 0; i < 16; ++i) { o0[i] = 0.f; o1[i] = 0.f; }
#pragma unroll
            for (int T = 0; T < 5; ++T) {
                if (T == 1) {
#pragma unroll
                    for (int T2 = 3; T2 < 5; ++T2)
#pragma unroll
                        for (int c = 0; c < 4; ++c) { const int kposn = va0 + (32 * T2 + 8 * c) * dil;
                            vf[T2][c] = *(const u32x4*)(Vb + (size_t)((unsigned)(kposn < 0 ? 0 : kposn) * 128u + (unsigned)((lane & 7) * 16))); }
                }
#pragma unroll
                for (int c = 0; c < 4; ++c) { const int chunk = lane + 64 * c, vr = chunk >> 3, vc = chunk & 7;
                    *(LAS u32x4*)(Vsh + vr * 144 + vc * 16) = vf[T][c]; }
                __builtin_amdgcn_sched_barrier(0);
#pragma unroll
                for (int s2 = 0; s2 < 2; ++s2) {
                    bf16x8 pb;
#pragma unroll
                    for (int j = 0; j < 8; j += 2) { const unsigned w = pk2(X[T][8 * s2 + j], X[T][8 * s2 + j + 1]); pb[j] = (short)(w & 0xffffu); pb[j + 1] = (short)(w >> 16); }
                    const s16x4 a0lo = vtr(vtb + (16 * s2) * 144),      a0hi = vtr(vtb + (16 * s2 + 8) * 144);
                    const s16x4 a1lo = vtr(vtb + (16 * s2) * 144 + 64), a1hi = vtr(vtb + (16 * s2 + 8) * 144 + 64);
                    const bf16x8 va0 = (bf16x8){a0lo[0], a0lo[1], a0lo[2], a0lo[3], a0hi[0], a0hi[1], a0hi[2], a0hi[3]};
                    const bf16x8 va1 = (bf16x8){a1lo[0], a1lo[1], a1lo[2], a1lo[3], a1hi[0], a1hi[1], a1hi[2], a1hi[3]};
                    o0 = __builtin_amdgcn_mfma_f32_32x32x16_bf16(va0, pb, o0, 0, 0, 0);
                    o1 = __builtin_amdgcn_mfma_f32_32x32x16_bf16(va1, pb, o1, 0, 0, 0);
                }
                __builtin_amdgcn_sched_barrier(0);
            }
#pragma unroll
            for (int u = 0; u < 4; ++u) __builtin_nontemporal_store(cpv[u], (f32x4*)(cp_dst + (size_t)cpo[u]));
#undef CP_OFF
            const float inv = 1.f / l; float L2 = m + __builtin_amdgcn_logf(l);
            const int ql = qpos - t0;
            float wo = 0.f, wn = inv;
            if (p > 0) { const float Lold = Lsh[ql]; const float mx = fmaxf(Lold, L2);
                const float Ln = mx + __builtin_amdgcn_logf(__builtin_amdgcn_exp2f(Lold - mx) + __builtin_amdgcn_exp2f(L2 - mx));
                wo = __builtin_amdgcn_exp2f(Lold - Ln); wn = __builtin_amdgcn_exp2f(L2 - Ln) * inv; L2 = Ln; }
#pragma unroll
            for (int dh = 0; dh < 2; ++dh)
#pragma unroll
                for (int g4 = 0; g4 < 4; ++g4) {
                    LAS u32x2* op = (LAS u32x2*)(Osh + ql * OSH_STRIDE + (32 * dh + 8 * g4 + 4 * hh) * 2);
                    float v0, v1, v2, v3;
                    if (dh == 0) { v0 = o0[4 * g4] * wn; v1 = o0[4 * g4 + 1] * wn; v2 = o0[4 * g4 + 2] * wn; v3 = o0[4 * g4 + 3] * wn; }
                    else         { v0 = o1[4 * g4] * wn; v1 = o1[4 * g4 + 1] * wn; v2 = o1[4 * g4 + 2] * wn; v3 = o1[4 * g4 + 3] * wn; }
                    if (p > 0) { const u32x2 old = *op; v0 += bflo(old.x) * wo; v1 += bfhi(old.x) * wo; v2 += bflo(old.y) * wo; v3 += bfhi(old.y) * wo; }
                    u32x2 nw; nw.x = pk2(v0, v1); nw.y = pk2(v2, v3); *op = nw;
                }
            if (hh == 0) Lsh[ql] = L2;
        }
        __syncthreads();
    }
    const int tid = otid(wid);
#pragma unroll
    for (int it = 0; it < 8; ++it) { const int chunk = tid + 512 * it, row = chunk >> 3, c = chunk & 7;
        const u32x4 ov = *(const LAS u32x4*)(Osh + row * OSH_STRIDE + c * 16);
        const size_t grow = rowbase + t0 + row;
        const u32x4 gv = __builtin_nontemporal_load((const u32x4*)(Z + grow * INW + C_GA + h * HD + c * 8));
        u32x4 w;
        w.x = pk2(bflo(ov.x) * silu(bflo(gv.x)), bfhi(ov.x) * silu(bfhi(gv.x)));
        w.y = pk2(bflo(ov.y) * silu(bflo(gv.y)), bfhi(ov.y) * silu(bfhi(gv.y)));
        w.z = pk2(bflo(ov.z) * silu(bflo(gv.z)), bfhi(ov.z) * silu(bfhi(gv.z)));
        w.w = pk2(bflo(ov.w) * silu(bflo(gv.w)), bfhi(ov.w) * silu(bfhi(gv.w)));
        *(u32x4*)(MIX + grow * DM + h * HD + c * 8) = w; }
    __syncthreads();
}

template <int W>
__device__ __forceinline__ void pooled_item(const bf16_t* up, bf16_t* pp, int row0, int pos0) {
    u32x4 R[W + 7];
#pragma unroll
    for (int k = 0; k < W + 7; ++k) { const int d = k - (W - 1);
        R[k] = (pos0 + d >= 0) ? *(const u32x4*)(up + (size_t)(row0 + d) * INW) : (u32x4){0u, 0u, 0u, 0u}; }
    float S[8];
#pragma unroll
    for (int c = 0; c < 8; ++c) S[c] = 0.f;
#pragma unroll
    for (int k = 0; k < W - 1; ++k) { S[0] += bflo(R[k].x); S[1] += bfhi(R[k].x); S[2] += bflo(R[k].y); S[3] += bfhi(R[k].y); S[4] += bflo(R[k].z); S[5] += bfhi(R[k].z); S[6] += bflo(R[k].w); S[7] += bfhi(R[k].w); }
#pragma unroll
    for (int j = 0; j < 8; ++j) {
        const u32x4 v = R[W - 1 + j], q = R[j];
        const float c[8] = {bflo(v.x), bfhi(v.x), bflo(v.y), bfhi(v.y), bflo(v.z), bfhi(v.z), bflo(v.w), bfhi(v.w)};
        const int pos = pos0 + j; const float icnt = 1.f / (float)((pos + 1 < W) ? pos + 1 : W);
        float o[8];
#pragma unroll
        for (int k = 0; k < 8; ++k) { S[k] += c[k]; o[k] = S[k] * icnt - c[k]; }
        u32x4 ov; ov.x = pk2(o[0], o[1]); ov.y = pk2(o[2], o[3]); ov.z = pk2(o[4], o[5]); ov.w = pk2(o[6], o[7]);
        *(u32x4*)(pp + (size_t)(row0 + j) * 256) = ov;
        S[0] -= bflo(q.x); S[1] -= bfhi(q.x); S[2] -= bflo(q.y); S[3] -= bfhi(q.y); S[4] -= bflo(q.z); S[5] -= bfhi(q.z); S[6] -= bflo(q.w); S[7] -= bfhi(q.w);
    }
}

template <int CH>
__device__ __forceinline__ void pool_tile16(LAS unsigned char* lds, const bf16x8 (&tf)[8]  , const bf16_t* zrow  , bf16_t* orow  ,
                                            const float* pool_scale, int g, int fr, int fq, int nt0, int nchunks) {
    u32x2 gvv[CH], gvn[CH]; f32x4 scv[CH], scn[CH];
#pragma unroll
    for (int k = 0; k < CH; ++k) { const int c = g * 256 + (nt0 + k) * 16 + 4 * fq; gvv[k] = *(const u32x2*)(zrow + C_GP + c); scv[k] = *(const f32x4*)(pool_scale + c); }
#pragma unroll 1
    for (int ch = 0; ch < nchunks; ++ch) {
        const int chn = (ch + 1 < nchunks) ? ch + 1 : ch;
#pragma unroll
        for (int k = 0; k < CH; ++k) { const int c = g * 256 + (nt0 + CH * chn + k) * 16 + 4 * fq; gvn[k] = *(const u32x2*)(zrow + C_GP + c); scn[k] = *(const f32x4*)(pool_scale + c); }
#pragma unroll
        for (int k = 0; k < CH; ++k) {
            const int nt = nt0 + CH * ch + k;
            f32x4 acc = (f32x4){0.f, 0.f, 0.f, 0.f};
#pragma unroll
            for (int s = 0; s < 8; ++s) { const bf16x8 wf = *(const LAS bf16x8*)(lds + (nt * 16 + fr) * 528 + (32 * s + 8 * fq) * 2);
                acc = __builtin_amdgcn_mfma_f32_16x16x32_bf16(wf, tf[s], acc, 0, 0, 0); }
            const int c = g * 256 + nt * 16 + 4 * fq;
            const f32x4 sc = scv[k]; const u32x2 gv = gvv[k];
            u32x2 w; w.x = pk2(acc[0] * sc.x * silu(bflo(gv.x)), acc[1] * sc.y * silu(bfhi(gv.x))); w.y = pk2(acc[2] * sc.z * silu(bflo(gv.y)), acc[3] * sc.w * silu(bfhi(gv.y)));
            *(u32x2*)(orow + AW + c) = w;
        }
#pragma unroll
        for (int k = 0; k < CH; ++k) { gvv[k] = gvn[k]; scv[k] = scn[k]; }
    }
}
__device__ __forceinline__ void pool_stage(LAS unsigned char* lds, const bf16_t* WPOOL, int g, int tid) {
    const bf16_t* Wg = WPOOL + (size_t)g * 65536;
    u32x4 wv[16];
#pragma unroll
    for (int k = 0; k < 16; ++k) { const int i = tid + 512 * k; wv[k] = *(const u32x4*)(Wg + (i >> 5) * 256 + (i & 31) * 8); }
#pragma unroll
    for (int k = 0; k < 16; ++k) { const int i = tid + 512 * k; *(LAS u32x4*)(lds + (i >> 5) * 528 + (i & 31) * 16) = wv[k]; }
}
__device__ __forceinline__ void pool_unit(LAS unsigned char* lds, const bf16_t* POOLED, const bf16_t* POOLEDS, const bf16_t* WPOOL, const bf16_t* Z, bf16_t* MIX, const float* pool_scale, int g, int rb, int tid, bool staged) {
    const int lane = tid & 63, wave = tid >> 6, fr = lane & 15, fq = lane >> 4;
    const int row = rb * 128 + wave * 16 + fr;
    bf16x8 tf[8];
    { const bf16_t* arow = POOLED + ((size_t)g * MP + row) * 256 + fq * 8;
#pragma unroll
      for (int s = 0; s < 8; ++s) tf[s] = *(const bf16x8*)(arow + 32 * s); }
    if (!staged) pool_stage(lds, WPOOL, g, tid);
    __syncthreads();
    pool_tile16<4>(lds, tf, Z + (size_t)row * INW, MIX + (size_t)row * DM, pool_scale, g, fr, fq, 0, 4);
    if (rb == 0) {
#pragma unroll 1
        for (int hf = 0; hf < 2; ++hf) { const int srow = hf * 16 + fr; bf16x8 ts[8];
            { const bf16_t* arow = POOLEDS + ((size_t)g * MS + srow) * 256 + fq * 8;
#pragma unroll
              for (int s = 0; s < 8; ++s) ts[s] = *(const bf16x8*)(arow + 32 * s); }
            pool_tile16<2>(lds, ts, Z + (size_t)(MP + srow) * INW, MIX + (size_t)(MP + srow) * DM, pool_scale, g, fr, fq, 2 * wave, 1); }
    }
    __syncthreads();
}

__device__ __forceinline__ void attn_sample_round(LAS unsigned char* lds, const Args& a, const bf16_t* Z, bf16_t* MIX, int task, int tid) {
    const int lane = tid & 63, wave = tid >> 6, q4 = wave & 3, half = wave >> 2;
    LAS float* msh = (LAS float*)(lds + 8192);
    const bool act = task < DB * DT * NH;
    const int h = task & 15, t = (task >> 4) & 3, b = (task >> 6) & 7;
    const size_t zrow = (size_t)(MP + b * DT + t) * INW;
    if (act) {
        const float* ks = a.out + O_KS; const float* vs = a.out + O_VS;
        const int slot = lane >> 4, c4 = lane & 15, e0 = 97 * q4;
        float qv[4];
        { const u32x2 w = *(const u32x2*)(Z + zrow + C_Q + h * HD + 4 * c4); qv[0] = bflo(w.x); qv[1] = bfhi(w.x); qv[2] = bflo(w.y); qv[3] = bfhi(w.y); }
        float sc[25]; float m = -INFINITY;
#pragma unroll
        for (int i = 0; i < 25; ++i) {
            const int el = slot + 4 * i, e = e0 + el; const bool valid = (el < 97) && (e < 387); const int ec = valid ? e : 0;
            const int p = (ec >= 129) + (ec >= 258), j = ec - 129 * p, R = BUF + t - (j << (2 * p));
            const float* kr = (R < BUF) ? a.cache_k + ((size_t)(b * BUF + R) * NH + h) * HD : ks + ((size_t)(b * BUF + R - DT) * NH + h) * HD;
            const f32x4 kv = *(const f32x4*)(kr + 4 * c4);
            float s = (qv[0] * kv.x + qv[1] * kv.y) + (qv[2] * kv.z + qv[3] * kv.w);
            s += __shfl_xor(s, 1); s += __shfl_xor(s, 2); s += __shfl_xor(s, 4); s += __shfl_xor(s, 8);
            s = valid ? s * 0.125f * LOG2E : -INFINITY; sc[i] = s; m = fmaxf(m, s);
        }
        m = fmaxf(m, __shfl_xor(m, 16)); m = fmaxf(m, __shfl_xor(m, 32));
        float l = 0.f;
#pragma unroll
        for (int i = 0; i < 25; ++i) { const float pe = __builtin_amdgcn_exp2f(sc[i] - m); sc[i] = pe; l += pe; }
        l += __shfl_xor(l, 16); l += __shfl_xor(l, 32);
        f32x4 acc = (f32x4){0.f, 0.f, 0.f, 0.f};
#pragma unroll
        for (int i = 0; i < 25; ++i) {
            const int el = slot + 4 * i, e = e0 + el; const bool valid = (el < 97) && (e < 387); const int ec = valid ? e : 0;
            const float pe = sc[i];
            const int p = (ec >= 129) + (ec >= 258), j = ec - 129 * p, R = BUF + t - (j << (2 * p));
            const float* vr = (R < BUF) ? a.cache_v + ((size_t)(b * BUF + R) * NH + h) * HD : vs + ((size_t)(b * BUF + R - DT) * NH + h) * HD;
            const f32x4 vv = *(const f32x4*)(vr + 4 * c4);
            acc.x += pe * vv.x; acc.y += pe * vv.y; acc.z += pe * vv.z; acc.w += pe * vv.w;
        }
        acc.x += __shfl_xor(acc.x, 16); acc.y += __shfl_xor(acc.y, 16); acc.z += __shfl_xor(acc.z, 16); acc.w += __shfl_xor(acc.w, 16);
        acc.x += __shfl_xor(acc.x, 32); acc.y += __shfl_xor(acc.y, 32); acc.z += __shfl_xor(acc.z, 32); acc.w += __shfl_xor(acc.w, 32);
        if (lane < 16) { LAS float* d = msh + wave * 68 + 4 * c4; d[0] = acc.x; d[1] = acc.y; d[2] = acc.z; d[3] = acc.w; }
        if (lane == 0) { msh[wave * 68 + 64] = m; msh[wave * 68 + 65] = l; }
    }
    __syncthreads();
    if (act && q4 == 0 && lane < 16) {
        const LAS float* s0 = msh + (half * 4) * 68;
        const float m0 = s0[64], m1 = s0[68 + 64], m2 = s0[136 + 64], m3 = s0[204 + 64];
        const float M = fmaxf(fmaxf(m0, m1), fmaxf(m2, m3));
        const float w0 = __builtin_amdgcn_exp2f(m0 - M), w1 = __builtin_amdgcn_exp2f(m1 - M), w2 = __builtin_amdgcn_exp2f(m2 - M), w3 = __builtin_amdgcn_exp2f(m3 - M);
        const float L = s0[65] * w0 + s0[68 + 65] * w1 + s0[136 + 65] * w2 + s0[204 + 65] * w3;
        const float inv = 1.f / L;
        float o[4];
#pragma unroll
        for (int k = 0; k < 4; ++k) o[k] = (s0[4 * lane + k] * w0 + s0[68 + 4 * lane + k] * w1 + s0[136 + 4 * lane + k] * w2 + s0[204 + 4 * lane + k] * w3) * inv;
        const u32x2 gv = *(const u32x2*)(Z + zrow + C_GA + h * HD + 4 * lane);
        u32x2 w; w.x = pk2(o[0] * silu(bflo(gv.x)), o[1] * silu(bfhi(gv.x))); w.y = pk2(o[2] * silu(bflo(gv.y)), o[3] * silu(bfhi(gv.y)));
        *(u32x2*)(MIX + (size_t)(MP + b * DT + t) * DM + h * HD + 4 * lane) = w;
    }
    __syncthreads();
}

__global__ void __launch_bounds__(512, 2) hymba_fwd(Args a) {
    extern __shared__ __attribute__((aligned(16))) unsigned char lds_raw[];
    LAS unsigned char* lds = (LAS unsigned char*)lds_raw;
    cg::grid_group grid = cg::this_grid();
    if (a.ws == nullptr) grid.sync();
    if (threadIdx.x < 4) ((volatile LAS unsigned*)(lds + LDS_BYTES - 64))[threadIdx.x] = 0u;
    __syncthreads();
    const XcdBarrier xbar = xcd_barrier_post((unsigned*)(a.ws + WS_BAR), (volatile LAS unsigned*)(lds + LDS_BYTES - 64));
    const int G = gridDim.x, bx = blockIdx.x;
    const int wave0 = __builtin_amdgcn_readfirstlane(threadIdx.x >> 6);
    const int vcu = osgpr((G % 8 == 0) ? (bx % 8) * (G / 8) + bx / 8 : bx);
#define PHASE_IDS const int tid = otid(wave0), lane = tid & 63, wave = wave0; \
    const int gw = osgpr(vcu * 8 + wave), NGW = G * 8, gt = osgpr(vcu * 512) + tid, NGT = G * 512; (void)gw; (void)NGW; (void)gt; (void)NGT; (void)lane;
    unsigned char* ws = a.ws;
    bf16_t* WIN = (bf16_t*)(ws + WS_WIN); bf16_t* WOUT = (bf16_t*)(ws + WS_WOUT); bf16_t* WPOOL = (bf16_t*)(ws + WS_WPOOL);
    bf16_t* XN = (bf16_t*)(ws + WS_XN); bf16_t* Z = (bf16_t*)(ws + WS_Z); bf16_t* MIX = (bf16_t*)(ws + WS_MIX);
    bf16_t* POOLED = (bf16_t*)(ws + WS_POOLED); bf16_t* POOLEDS = (bf16_t*)(ws + WS_POOLEDS);

#if PHM & 1
    for (int rep_ = 0; rep_ < 1 + ((PHDUP >> 0) & 1); ++rep_) {
        PHASE_IDS
        LAS float* scr = (LAS float*)(lds + wave * 16384);
        constexpr int I_IN = (DM / 64) * (INW / 32), I_OUT = (DM / 64) * (DM / 32), I_PL = (256 / 64) * (256 / 32);
        constexpr int NITEMS = I_IN + 4 * I_PL;
        for (int it = gw; it < NITEMS; it += NGW) {
            int r = it;
            if (r < I_IN) { p0_transpose_item(a.w_in, DM, INW, WIN, scr, r, lane); continue; } r -= I_IN;
            const int g = r / I_PL; r -= g * I_PL;
            p0_transpose_item(a.w_pool + (size_t)g * 65536, 256, 256, WPOOL + (size_t)g * 65536, scr, r, lane);
        }
        for (int m = gw; m < MT; m += NGW) {
            const float* xr = (m < MP) ? a.x_prompt + (size_t)m * DM : a.x_sample + (size_t)(m - MP) * DM;
            rms_row_to_bf16(xr, a.norm_g, XN + (size_t)m * DM, lane);
        }
        {
            for (int i0 = CP_ATT + gt; i0 < 2 * CP_N; i0 += 8 * NGT) {
                f32x4 cv[8]; f32x4* cd[8];
#pragma unroll
                for (int u = 0; u < 8; ++u) { const int i = i0 + u * NGT; const f32x4* sp; cp_addr(a, i < 2 * CP_N ? i : CP_ATT, sp, cd[u]); cv[u] = __builtin_nontemporal_load(sp); }
#pragma unroll
                for (int u = 0; u < 8; ++u) if (i0 + u * NGT < 2 * CP_N) __builtin_nontemporal_store(cv[u], cd[u]);
            }
            constexpr int PPER_B = (PH - DT) * PW / 4, NPP = DB * PPER_B;
            f32x4* pd = (f32x4*)(a.out + O_PS); const f32x4* psrc = (const f32x4*)a.state_pool;
            for (int i = gt; i < NPP; i += NGT) { const int b = i / PPER_B, o = i - b * PPER_B;
                pd[(size_t)b * (PH * PW / 4) + o] = psrc[(size_t)b * (PH * PW / 4) + DT * PW / 4 + o]; }
        }
    }
#endif
    GRID_SYNC();

#if PHM & 2
    for (int rep_ = 0; rep_ < 1 + ((PHDUP >> 1) & 1); ++rep_) {
        SEpiZ se{Z, a.out};
        small_gemm(lds, XN + (size_t)MP * DM, WIN, INW / 32, DM, bx, G, se, otid(wave0));
        pg8::Gemm g{XN, WIN, MP, INW, DM}; pg8::StaticOrder S; S.init(MP, INW, G, bx);
        EpiZ E{Z, a.out, (bf16_t*)(ws + WS_KC), (bf16_t*)(ws + WS_VC)};
        pg8::gemm_phase<EpiZ, pg8::StaticOrder, true, true>(lds, g, S, E, otid(wave0));
    }
#endif
    GRID_SYNC();

#if PHM & 4
    for (int rep_ = 0; rep_ < 1 + ((PHDUP >> 2) & 1); ++rep_) {
        PHASE_IDS
        for (int u = vcu; u < NB * NH * 8; u += G) attn_prompt_unit(lds, Z, MIX, u >> 7, (u >> 3) & 15, u & 7, wave0, a, u, (const bf16_t*)(ws + WS_KC), (const bf16_t*)(ws + WS_VC));
        {
            LAS float* scr = (LAS float*)(lds + wave * 16384);
            constexpr int I_OUT2 = (DM / 64) * (DM / 32);
            for (int it = gw; it < I_OUT2; it += NGW) p0_transpose_item(a.w_out, DM, DM, WOUT, scr, it, lane);
            __syncthreads();
        }
        for (int item = gt; item < 4 * (MP / 8) * 32; item += NGT) {
            const int cc = item & 31, rc = (item >> 5) & (MP / 8 - 1), g = item >> 15, row0 = rc * 8, pos0 = row0 & (SEQ - 1);
            const bf16_t* up = Z + C_U + g * 256 + cc * 8; bf16_t* pp = POOLED + ((size_t)g * MP) * 256 + cc * 8;
            if (g == 0) pooled_item<2>(up, pp, row0, pos0); else if (g == 1) pooled_item<4>(up, pp, row0, pos0);
            else if (g == 2) pooled_item<8>(up, pp, row0, pos0); else pooled_item<16>(up, pp, row0, pos0);
        }
        for (int i = gt; i < MS * PW; i += NGT) {
            const int c = i & (PW - 1), rw = i >> 10, b = rw >> 2, t = rw & 3, g = c >> 8, w = 2 << g;
            float s = 0.f, cur = 0.f;
#pragma unroll
            for (int k = 0; k < 16; ++k) if (k < w) { const int e = PH + t - k;
                const float v = (e < PH) ? a.state_pool[((size_t)b * PH + e) * PW + c] : __builtin_bit_cast(float, (unsigned)Z[(size_t)(MP + b * DT + e - PH) * INW + C_U + c] << 16);
                s += v; if (k == 0) cur = v; }
            POOLEDS[((size_t)g * MS + rw) * 256 + (c & 255)] = (bf16_t)f2bf(s / (float)w - cur);
        }
        if (vcu < 256) { __syncthreads(); pool_stage(lds, WPOOL, vcu >> 6, tid); }
    }
#endif
    GRID_SYNC();

#if PHM & 8
    for (int rep_ = 0; rep_ < 1 + ((PHDUP >> 3) & 1); ++rep_) {
        PHASE_IDS
        for (int u = vcu; u < 256; u += G) pool_unit(lds, POOLED, POOLEDS, WPOOL, Z, MIX, a.pool_scale, u >> 6, u & 63, tid, (u == vcu) && (PHDUP == 0));
        for (int pi = vcu; pi < DB * DT * NH / 2; pi += G) attn_sample_round(lds, a, Z, MIX, 2 * pi + (wave >> 2), tid);
    }
#endif
    GRID_SYNC();

#if PHM & 16
    for (int rep_ = 0; rep_ < 1 + ((PHDUP >> 4) & 1); ++rep_) {
        if (bx < DM / 32) sample_out_unit(lds, MIX + (size_t)MP * DM, WOUT, a.x_sample, a.out + O_YS, a.final_g, (float*)(ws + WS_SLOTS) + (size_t)MP * 8, (unsigned*)(ws + WS_CNT) + 64 * 32, bx, otid(wave0));
        pg8::Gemm g{MIX, WOUT, MP, DM, DM}; pg8::StaticOrder S; S.init(MP, DM, G, bx);
        EpiYN E{a.x_prompt, a.out + O_YP, a.final_g, (float*)(ws + WS_SLOTS), (unsigned*)(ws + WS_CNT)};
        pg8::gemm_phase<EpiYN, pg8::StaticOrder, false, true>(lds, g, S, E, otid(wave0));
    }
#endif
}

extern "C" void kernel_launch(void* const* d_in, const int* in_sizes, int n_in, void* d_out, int out_size, void* d_ws, size_t ws_size, hipStream_t stream) {
    static int grid = 0;
    if (grid == 0) {
        int dev = 0, cus = 0, per_cu = 0;
        hipGetDevice(&dev);
        hipDeviceGetAttribute(&cus, hipDeviceAttributeMultiprocessorCount, dev);
        if (hipFuncSetAttribute((const void*)hymba_fwd, hipFuncAttributeMaxDynamicSharedMemorySize, LDS_BYTES) != hipSuccess) { fprintf(stderr, "hipFuncSetAttribute failed\n"); grid = -1; return; }
        if (hipOccupancyMaxActiveBlocksPerMultiprocessor(&per_cu, (const void*)hymba_fwd, 512, LDS_BYTES) != hipSuccess || per_cu < 1) { fprintf(stderr, "occupancy query: %d\n", per_cu); per_cu = 1; }
        (void)hipGetLastError();
        grid = cus;
    }
    if (grid < 0) return;
    if (hipMemsetAsync(d_ws, 0, CTL_ZERO_BYTES, stream) != hipSuccess) { fprintf(stderr, "memset failed\n"); return; }
    Args a{};
    a.x_prompt = (const float*)d_in[0]; a.x_sample = (const float*)d_in[1]; a.cache_k = (const float*)d_in[2]; a.cache_v = (const float*)d_in[3];
    a.state_pool = (const float*)d_in[4]; a.norm_g = (const float*)d_in[5]; a.w_in = (const float*)d_in[6]; a.w_pool = (const float*)d_in[7];
    a.pool_scale = (const float*)d_in[8]; a.w_out = (const float*)d_in[9]; a.final_g = (const float*)d_in[10];
    a.out = (float*)d_out; a.ws = (unsigned char*)d_ws;
    void* args[] = {&a};
    hipError_t e = hipLaunchCooperativeKernel((const void*)hymba_fwd, dim3(grid), dim3(512), args, LDS_BYTES, stream);
    if (e != hipSuccess) fprintf(stderr, "cooperative launch failed: %s (grid %d)\n", hipGetErrorString(e), grid);
}
```

```cpp
#include <hip/hip_runtime.h>
#include <hip/hip_cooperative_groups.h>
#include <cstdio>
#include <cstdint>
namespace cg = cooperative_groups;
#define LAS __attribute__((address_space(3)))
namespace pg8 {
#define PG8_LAS __attribute__((address_space(3)))
typedef unsigned short bf16_t;
typedef short bf16x8 __attribute__((ext_vector_type(8)));
typedef float f32x4 __attribute__((ext_vector_type(4)));
typedef unsigned u32x4 __attribute__((ext_vector_type(4)));
constexpr int BM = 256, BK = 64, HALF = 128, HTB = HALF * BK * 2  , STAGE_BYTES = 8 * HTB, NXCD = 8, WGM = 8;

__host__ __device__ __forceinline__ int lds_byte(int r, int c) { const int st = (r >> 4) * 2 + (c >> 5), rr = r & 15, cc = c & 31, ob = rr * 64 + cc * 2; return st * 1024 + (ob ^ (((ob >> 9) & 1) << 5)); }
__host__ __device__ __forceinline__ void stage_rc(int b, int& R, int& C) { const int st = b / 1024, sb = b % 1024, swz = sb ^ (((sb >> 9) & 1) << 5); R = (st >> 1) * 16 + swz / 64; C = (st & 1) * 32 + (swz % 64) / 2; }
__host__ __device__ __forceinline__ int perm32(int rho) { const int n = rho >> 4, i = rho & 15; return 8 * (i >> 2) + 4 * n + (i & 3); }

struct Unit { int pm, pn; };
struct Gemm { const bf16_t* A; const bf16_t* Bt; int M, N, K; };

struct StaticOrder {
    int nM, nN, nwg, G, c;
    __host__ __device__ void init(int M, int N, int G_, int c_) { nM = M / BM; nN = N / BM; nwg = nM * nN; G = G_; c = c_; }
    __host__ __device__ bool next(int i, Unit& u) const {
        const long L = (long)i * G + c; if (L >= nwg) return false;
        int wgid = (int)L; { const int q = nwg / NXCD, r = nwg % NXCD, xcd = wgid % NXCD, off = wgid / NXCD; wgid = (xcd < r ? xcd * (q + 1) : r * (q + 1) + (xcd - r) * q) + off; }
        const int nig = WGM * nN, gid = wgid / nig, fm = gid * WGM, gsz = (nM - fm) < WGM ? (nM - fm) : WGM;
        u.pm = fm + ((wgid % nig) % gsz); u.pn = (wgid % nig) / gsz; return true;
    }
    __device__ __forceinline__ void a_ready(const Unit&) const {}
    __device__ __forceinline__ void done(const Unit&) const {}
};

__device__ __forceinline__ unsigned cvt_pk_bf16(float lo, float hi) { unsigned r; asm volatile("v_cvt_pk_bf16_f32 %0, %1, %2" : "=v"(r) : "v"(lo), "v"(hi)); return r; }
template <class Epi, class Sched, bool ALIGN_EPI = false, bool SP2 = false>
__device__ __forceinline__ void gemm_phase(PG8_LAS unsigned char* lds, const Gemm g, const Sched& S, const Epi& E, const int tid_in) {
    int tid_ = tid_in; asm volatile("" : "+v"(tid_));
    const int tid = tid_, wid = __builtin_amdgcn_readfirstlane(tid >> 6), lane = tid & 63, wr = wid >> 2, wc = wid & 3, fr = lane & 15, fq = lane >> 4;
    const int K = g.K, nt = K / BK;
    unsigned voffA[2], voffB[2];
#pragma unroll
    for (int i = 0; i < 2; ++i) { int R, C; stage_rc(tid * 16 + i * 8192, R, C); const int Rb = Epi::PERM ? ((R & ~31) + perm32(R & 31)) : R;
        voffA[i] = (unsigned)(R * K + C) * 2u; voffB[i] = (unsigned)(Rb * K + C) * 2u; }
    const size_t kstep = (size_t)(BK * 2);
    const size_t hstep = (size_t)HALF * K * 2;
    const size_t tstep = 2 * hstep;
    const unsigned ldsw = (unsigned)wid * 1024u;
    const int aoff = lds_byte(wr * 64 + fr, fq * 8), boff = lds_byte(wc * 32 + fr, fq * 8);
#define PG8_SA(b, h) (((b) * 2 + (h)) * HTB)
#define PG8_SB(b, h) ((4 + (b) * 2 + (h)) * HTB)
#define PG8_STAGE(bufoff, gbase, voff) do { _Pragma("unroll") for (int _i = 0; _i < 2; ++_i) \
        __builtin_amdgcn_global_load_lds((const unsigned*)((const char*)(gbase) + (voff)[_i]), (PG8_LAS unsigned*)(lds + (bufoff) + ldsw + _i * 8192), 16, 0, 0); } while (0)
#define PG8_LDA(dst, b, h) do { _Pragma("unroll") for (int m = 0; m < 4; ++m) _Pragma("unroll") for (int k = 0; k < 2; ++k) dst[m][k] = *(const PG8_LAS bf16x8*)(lds + PG8_SA(b, h) + aoff + m * 2048 + k * 1024); } while (0)
#define PG8_LDB(dst, b, h) do { _Pragma("unroll") for (int n = 0; n < 2; ++n) _Pragma("unroll") for (int k = 0; k < 2; ++k) dst[n][k] = *(const PG8_LAS bf16x8*)(lds + PG8_SB(b, h) + boff + n * 2048 + k * 1024); } while (0)
#define PG8_MMA(ai, bj, At, Bt) do { __builtin_amdgcn_s_setprio(1); _Pragma("unroll") for (int m = 0; m < 4; ++m) _Pragma("unroll") for (int n = 0; n < 2; ++n) _Pragma("unroll") for (int k = 0; k < 2; ++k) \
        acc[ai][bj][m][n] = __builtin_amdgcn_mfma_f32_16x16x32_bf16(Bt[n][k], At[m][k], acc[ai][bj][m][n], 0, 0, 0); __builtin_amdgcn_s_setprio(0); } while (0)
#define PG8_WAIT_V(n) asm volatile("s_waitcnt vmcnt(" #n ")" ::: "memory")
#define PG8_WAIT_L(n) asm volatile("s_waitcnt lgkmcnt(" #n ")" ::: "memory")
#define PG8_BAR __builtin_amdgcn_s_barrier()
#define PG8_SCHED __builtin_amdgcn_sched_barrier(0)
    Unit cur, nxt; int ui = 0;
    if (!S.next(0, cur)) return;
    f32x4 acc[2][2][4][2];
#pragma unroll
    for (int a = 0; a < 2; ++a)
#pragma unroll
        for (int b = 0; b < 2; ++b)
#pragma unroll
            for (int m = 0; m < 4; ++m)
#pragma unroll
                for (int n = 0; n < 2; ++n) acc[a][b][m][n] = (f32x4){0.f, 0.f, 0.f, 0.f};
    bf16x8 At[4][2], B0[2][2], B1[2][2];
    const char* cA = (const char*)g.A + (size_t)cur.pm * tstep; const char* cB = (const char*)g.Bt + (size_t)cur.pn * tstep;
    S.a_ready(cur);
    if constexpr (SP2) {
        PG8_STAGE(PG8_SB(0, 0), cB, voffB); PG8_STAGE(PG8_SB(0, 1), cB + hstep, voffB); PG8_STAGE(PG8_SA(0, 0), cA, voffA); PG8_STAGE(PG8_SA(0, 1), cA + hstep, voffA);
        if (wr == 1) PG8_BAR;
        PG8_WAIT_V(2); PG8_BAR;
        PG8_STAGE(PG8_SB(1, 0), cB + kstep, voffB); PG8_STAGE(PG8_SA(1, 0), cA + kstep, voffA); PG8_STAGE(PG8_SB(1, 1), cB + hstep + kstep, voffB);
        PG8_WAIT_V(6); PG8_BAR;
    } else {
        PG8_STAGE(PG8_SB(0, 0), cB, voffB); PG8_STAGE(PG8_SA(0, 0), cA, voffA); PG8_STAGE(PG8_SB(0, 1), cB + hstep, voffB); PG8_STAGE(PG8_SA(0, 1), cA + hstep, voffA);
        if (wr == 1) PG8_BAR;
        PG8_WAIT_V(4); PG8_BAR;
        PG8_STAGE(PG8_SB(1, 0), cB + kstep, voffB); PG8_STAGE(PG8_SA(1, 0), cA + kstep, voffA); PG8_STAGE(PG8_SB(1, 1), cB + hstep + kstep, voffB);
        PG8_WAIT_V(6); PG8_BAR;
    }
    for (;;) {
        const bool has_next = S.next(ui + 1, nxt);
        const char* nA = has_next ? (const char*)g.A + (size_t)nxt.pm * tstep : cA; const char* nB = has_next ? (const char*)g.Bt + (size_t)nxt.pn * tstep : cB;
        for (int t = 0; t < nt; t += 2) {
            const bool last = (t == nt - 2);
            const char* a1 = cA + (size_t)(t + 1) * kstep;
            const char* a2 = last ? nA : cA + (size_t)(t + 2) * kstep; const char* b2 = last ? nB : cB + (size_t)(t + 2) * kstep;
            const char* a3 = a2 + kstep; const char* b3 = b2 + kstep;
            if (last && has_next) S.a_ready(nxt);
            if constexpr (SP2) {
            PG8_LDB(B0, 0, 0); PG8_LDB(B1, 0, 1); PG8_SCHED; PG8_LDA(At, 0, 0); PG8_STAGE(PG8_SA(1, 1), a1 + hstep, voffA);
            PG8_WAIT_V(8); PG8_WAIT_L(0); PG8_BAR; PG8_MMA(0, 0, At, B0); PG8_MMA(0, 1, At, B1); PG8_BAR; PG8_SCHED;
            PG8_LDA(At, 0, 1); PG8_STAGE(PG8_SB(0, 0), b2, voffB); PG8_STAGE(PG8_SB(0, 1), b2 + hstep, voffB); PG8_STAGE(PG8_SA(0, 0), a2, voffA);
            PG8_WAIT_V(8); PG8_WAIT_L(0); PG8_BAR; PG8_MMA(1, 0, At, B0); PG8_MMA(1, 1, At, B1); PG8_BAR; PG8_SCHED;
            PG8_LDB(B0, 1, 0); PG8_LDB(B1, 1, 1); PG8_SCHED; PG8_LDA(At, 1, 0); PG8_STAGE(PG8_SA(0, 1), a2 + hstep, voffA);
            PG8_WAIT_V(8); PG8_WAIT_L(0); PG8_BAR; PG8_MMA(0, 0, At, B0); PG8_MMA(0, 1, At, B1); PG8_BAR; PG8_SCHED;
            PG8_LDA(At, 1, 1); PG8_STAGE(PG8_SB(1, 0), b3, voffB); PG8_STAGE(PG8_SB(1, 1), b3 + hstep, voffB); PG8_STAGE(PG8_SA(1, 0), a3, voffA);
            PG8_WAIT_V(8); PG8_WAIT_L(0); PG8_BAR; PG8_MMA(1, 0, At, B0); PG8_MMA(1, 1, At, B1); PG8_BAR; PG8_SCHED;
            } else {
            PG8_LDB(B0, 0, 0); PG8_SCHED; PG8_LDA(At, 0, 0); PG8_STAGE(PG8_SA(1, 1), a1 + hstep, voffA);
            PG8_WAIT_L(8); PG8_BAR; PG8_WAIT_L(0); PG8_MMA(0, 0, At, B0); PG8_BAR; PG8_SCHED;
            PG8_LDB(B1, 0, 1); PG8_STAGE(PG8_SB(0, 0), b2, voffB);
            PG8_BAR; PG8_WAIT_L(0); PG8_MMA(0, 1, At, B1); PG8_BAR;
            PG8_LDA(At, 0, 1); PG8_STAGE(PG8_SA(0, 0), a2, voffA);
            PG8_BAR; PG8_WAIT_L(0); PG8_MMA(1, 0, At, B0); PG8_BAR; PG8_SCHED;
            PG8_STAGE(PG8_SB(0, 1), b2 + hstep, voffB);
            PG8_WAIT_V(6); PG8_BAR; PG8_MMA(1, 1, At, B1); PG8_BAR;
            PG8_LDB(B0, 1, 0); PG8_SCHED; PG8_LDA(At, 1, 0); PG8_STAGE(PG8_SA(0, 1), a2 + hstep, voffA);
            PG8_WAIT_L(8); PG8_BAR; PG8_WAIT_L(0); PG8_MMA(0, 0, At, B0); PG8_BAR; PG8_SCHED;
            PG8_LDB(B1, 1, 1); PG8_STAGE(PG8_SB(1, 0), b3, voffB);
            PG8_BAR; PG8_WAIT_L(0); PG8_MMA(0, 1, At, B1); PG8_BAR;
            PG8_LDA(At, 1, 1); PG8_STAGE(PG8_SA(1, 0), a3, voffA);
            PG8_BAR; PG8_WAIT_L(0); PG8_MMA(1, 0, At, B0); PG8_BAR; PG8_SCHED;
            PG8_STAGE(PG8_SB(1, 1), b3 + hstep, voffB);
            PG8_WAIT_V(6); PG8_BAR; PG8_MMA(1, 1, At, B1); PG8_BAR;
            }
        }
        if constexpr (ALIGN_EPI) { if (wr == 0) PG8_BAR; }
        if constexpr (!Epi::AFTER_DRAIN) { E(acc, cur, wr, wc, fr, fq); S.done(cur); }
        if (!has_next) break;
#pragma unroll
        for (int a = 0; a < 2; ++a)
#pragma unroll
            for (int b = 0; b < 2; ++b)
#pragma unroll
                for (int m = 0; m < 4; ++m)
#pragma unroll
                    for (int n = 0; n < 2; ++n) acc[a][b][m][n] = (f32x4){0.f, 0.f, 0.f, 0.f};
        cur = nxt; cA = nA; cB = nB; ++ui;
        if constexpr (ALIGN_EPI) { if (wr == 1) PG8_BAR; }
    }
    PG8_WAIT_V(0);
    if constexpr (!ALIGN_EPI) { if (wr == 0) PG8_BAR; }
    PG8_BAR;
    if constexpr (Epi::AFTER_DRAIN) { E.fused(acc, cur, wr, wc, fr, fq, lds, wid, lane); S.done(cur); }
#undef PG8_SA
#undef PG8_SB
#undef PG8_STAGE
#undef PG8_LDA
#undef PG8_LDB
#undef PG8_MMA
#undef PG8_WAIT_V
#undef PG8_WAIT_L
#undef PG8_BAR
#undef PG8_SCHED
}
}
#define XB_TMO      128
#define XB_XCNT(j)  (256  + 64 * (j))
#define XB_XSUB(j)  (1280 + 64 * (j))
#define XB_XGEN(j)  (2304 + 64 * (j))
#define XB_TOP      3328
#define XB_TOPGEN   3392
#define XCD_BAR_WORDS 3456
#define XB_SPIN_CAP (1u << 18)

__device__ __forceinline__ unsigned xb_ld(unsigned* p)              { return __hip_atomic_load(p, __ATOMIC_RELAXED, __HIP_MEMORY_SCOPE_AGENT); }
__device__ __forceinline__ unsigned xb_add(unsigned* p, unsigned v) { return __hip_atomic_fetch_add(p, v, __ATOMIC_RELAXED, __HIP_MEMORY_SCOPE_AGENT); }
__device__ __forceinline__ unsigned xb_xcc_id() { return (unsigned)__builtin_amdgcn_s_getreg((3 << 11) | 20) & 0xFu; }
#define XB_SPIN(cond, bar) do { unsigned _sp = 0; while (cond) { __builtin_amdgcn_s_sleep(1); \
    if ((++_sp & 255u) == 0u) { if (xb_ld(&(bar)[XB_TMO])) break; if (_sp > XB_SPIN_CAP) { atomicAdd(&(bar)[XB_TMO], 1u); break; } } } } while (0)

struct XcdBarrier {
    unsigned* bar; unsigned x;
    volatile LAS unsigned* st;
};

__device__ __forceinline__ XcdBarrier xcd_barrier_post(unsigned* bar, volatile LAS unsigned* st) {
    XcdBarrier b; b.bar = bar; b.x = xb_xcc_id(); b.st = st;
    if (threadIdx.x == 0) (void)xb_add(&bar[XB_XCNT(b.x)], 1u);
    return b;
}
__device__ __forceinline__ void xcd_barrier_complete(unsigned* bar, unsigned x, unsigned& nloc, unsigned& nx) {
    const unsigned G = gridDim.x * gridDim.y * gridDim.z;
    unsigned sum, cnt, mine, sp = 0u;
    for (;;) {
        sum = 0u; cnt = 0u; mine = 0u;
#pragma unroll
        for (unsigned j = 0; j < 16; ++j) { const unsigned c = xb_ld(&bar[XB_XCNT(j)]); sum += c; cnt += (c > 0u) ? 1u : 0u; mine = (j == x) ? c : mine; }
        if (sum == G) break;
        __builtin_amdgcn_s_sleep(1);
        if ((++sp & 255u) == 0u) { if (xb_ld(&bar[XB_TMO])) break; if (sp > XB_SPIN_CAP) { atomicAdd(&bar[XB_TMO], 1u); break; } }
    }
    nloc = mine > 0u ? mine : 1u; nx = cnt > 0u ? cnt : 1u;
}

__device__ __forceinline__ void xcd_barrier(const XcdBarrier& b) {
    asm volatile("s_waitcnt vmcnt(0)" ::: "memory");
    __syncthreads();
    if (threadIdx.x == 0) {
        unsigned* bar = b.bar;
        __builtin_amdgcn_s_waitcnt(0);
        unsigned nloc = b.st[0], nx = b.st[1];
        if (nloc == 0u) { xcd_barrier_complete(bar, b.x, nloc, nx); b.st[0] = nloc; b.st[1] = nx; }
        const unsigned old = xb_add(&bar[XB_XSUB(b.x)], 1u);
        const unsigned gen = old / nloc;
        if (old + 1u == (gen + 1u) * nloc) {
            __builtin_amdgcn_fence(__ATOMIC_RELEASE, "agent");
            asm volatile("s_waitcnt vmcnt(0)" ::: "memory");
            const unsigned og = xb_add(&bar[XB_TOP], 1u);
            const unsigned tg = og / nx;
            if (og + 1u == (tg + 1u) * nx) xb_add(&bar[XB_TOPGEN], 1u);
            else XB_SPIN(xb_ld(&bar[XB_TOPGEN]) == tg, bar);
            __builtin_amdgcn_fence(__ATOMIC_ACQUIRE, "agent");
            xb_add(&bar[XB_XGEN(b.x)], 1u);
            asm volatile("s_waitcnt vmcnt(0)" ::: "memory");
        } else {
            XB_SPIN(xb_ld(&bar[XB_XGEN(b.x)]) == gen, bar);
            __builtin_amdgcn_fence(__ATOMIC_ACQUIRE, "agent");
            asm volatile("s_waitcnt vmcnt(0)" ::: "memory");
        }
    }
    __syncthreads();
}

typedef unsigned short bf16_t;
typedef short bf16x8 __attribute__((ext_vector_type(8)));
typedef float f32x4 __attribute__((ext_vector_type(4)));
typedef float f32x16 __attribute__((ext_vector_type(16)));
typedef unsigned u32x4 __attribute__((ext_vector_type(4)));
typedef unsigned u32x2 __attribute__((ext_vector_type(2)));

constexpr int DM = 2048, SEQ = 4096, NB = 2, MP = NB * SEQ  , MS = 32  , MT = MP + MS;
constexpr int INW = 6144, AW = 1024, NH = 16, HD = 64, BUF = 2048, DB = 8, DT = 4, PH = 15, PW = 1024;
constexpr int C_Q = 0, C_K = 1024, C_V = 2048, C_GA = 3072, C_U = 4096, C_GP = 5120;
constexpr float EPS = 1e-6f;
constexpr float LOG2E = 1.4426950408889634f;

constexpr size_t O_YP = 0, O_YS = 16777216, O_KP = 16842752, O_VP = 21037056, O_PP = 25231360, O_KS = 25262080, O_VS = 42039296, O_PS = 58816512;

constexpr size_t MiB = 1u << 20;
constexpr size_t WS_CNT = 0  , WS_BAR = 65536, CTL_ZERO_BYTES = 131072, WS_SLOTS = 1 * MiB  , WS_WIN = 2 * MiB, WS_WOUT = 26 * MiB, WS_WPOOL = 34 * MiB, WS_XN = 36 * MiB, WS_Z = 70 * MiB, WS_MIX = 168 * MiB,
                 WS_POOLED = 202 * MiB, WS_POOLEDS = 219 * MiB, WS_KC = 220 * MiB, WS_VC = 238 * MiB;

constexpr int LDS_BYTES = 155648;
#ifndef PHM
#define PHM 63
#endif
#ifndef PHDUP
#define PHDUP 0
#endif
#ifndef SYNCDUP
#define SYNCDUP 1
#endif
#define GRID_SYNC() do { for (int s_ = 0; s_ < SYNCDUP; ++s_) xcd_barrier(xbar); } while (0)

struct Args {
    const float* x_prompt; const float* x_sample; const float* cache_k; const float* cache_v; const float* state_pool;
    const float* norm_g; const float* w_in; const float* w_pool; const float* pool_scale; const float* w_out; const float* final_g;
    float* out; unsigned char* ws;
};

__device__ __forceinline__ int otid(int wave_s) { int l; asm volatile("v_mbcnt_lo_u32_b32 %0, -1, 0\n\tv_mbcnt_hi_u32_b32 %0, -1, %0" : "=v"(l)); return wave_s * 64 + l; }
__device__ __forceinline__ int osgpr(int v) { asm volatile("" : "+s"(v)); return v; }
__device__ __forceinline__ unsigned f2bf(float f) { unsigned u = __builtin_bit_cast(unsigned, f); return (u + 0x7fffu + ((u >> 16) & 1u)) >> 16; }
typedef float f32x2_t __attribute__((ext_vector_type(2))); typedef __bf16 bf16x2_t __attribute__((ext_vector_type(2)));
__device__ __forceinline__ unsigned pk2(float lo, float hi) { f32x2_t v = {lo, hi}; bf16x2_t b = __builtin_convertvector(v, bf16x2_t); return __builtin_bit_cast(unsigned, b); }
__device__ __forceinline__ float bflo(unsigned w) { return __builtin_bit_cast(float, w << 16); }
__device__ __forceinline__ float bfhi(unsigned w) { return __builtin_bit_cast(float, w & 0xffff0000u); }
__device__ __forceinline__ float silu(float v) { return v * __builtin_amdgcn_rcpf(1.f + __builtin_amdgcn_exp2f(-1.4426950408889634f * v)); }
__device__ __forceinline__ float wave_sum(float v) {
#pragma unroll
    for (int o = 1; o < 64; o <<= 1) v += __shfl_xor(v, o);
    return v;
}
__device__ __forceinline__ float wave_max(float v) {
#pragma unroll
    for (int o = 1; o < 64; o <<= 1) v = fmaxf(v, __shfl_xor(v, o));
    return v;
}

__device__ __forceinline__ void p0_transpose_item(const float* W, int K, int N, bf16_t* WT, LAS float* scr, int item, int lane) {
    const int nblk = N / 32, kb = item / nblk, nb = item % nblk, k0 = 64 * kb, n0 = 32 * nb;
    f32x4 v[8];
#pragma unroll
    for (int i = 0; i < 8; ++i) v[i] = __builtin_nontemporal_load((const f32x4*)(W + (size_t)(k0 + 8 * i + (lane >> 3)) * N + n0 + 4 * (lane & 7)));
#pragma unroll
    for (int i = 0; i < 8; ++i) { LAS float* d = scr + (8 * i + (lane >> 3)) * 33 + 4 * (lane & 7); d[0] = v[i].x; d[1] = v[i].y; d[2] = v[i].z; d[3] = v[i].w; }
    asm volatile("s_waitcnt lgkmcnt(0)" ::: "memory");
    const int c = lane & 7;
#pragma unroll
    for (int j = 0; j < 4; ++j) { const int n = (lane >> 3) + 8 * j; const LAS float* s = scr + (8 * c) * 33 + n;
        u32x4 o; o.x = pk2(s[0 * 33], s[1 * 33]); o.y = pk2(s[2 * 33], s[3 * 33]); o.z = pk2(s[4 * 33], s[5 * 33]); o.w = pk2(s[6 * 33], s[7 * 33]);
        *(u32x4*)(WT + (size_t)(n0 + n) * K + k0 + 8 * c) = o; }
    asm volatile("s_waitcnt lgkmcnt(0)" ::: "memory");
}

__device__ __forceinline__ void rms_row_to_bf16(const float* xrow, const float* g, bf16_t* orow, int lane) {
    const f32x4* xr = (const f32x4*)xrow + lane; const f32x4* gr = (const f32x4*)g + lane;
    f32x4 v[8]; float s = 0.f;
#pragma unroll
    for (int j = 0; j < 8; ++j) { v[j] = __builtin_nontemporal_load(xr + 64 * j); s += (v[j].x * v[j].x + v[j].y * v[j].y) + (v[j].z * v[j].z + v[j].w * v[j].w); }
    const float rs = 1.f / sqrtf(wave_sum(s) * (1.f / DM) + EPS);
    u32x2* o8 = (u32x2*)orow + lane;
#pragma unroll
    for (int j = 0; j < 8; ++j) { const f32x4 gg = gr[64 * j]; u32x2 w; w.x = pk2(v[j].x * rs * gg.x, v[j].y * rs * gg.y); w.y = pk2(v[j].z * rs * gg.z, v[j].w * rs * gg.w); o8[64 * j] = w; }
}

struct EpiZ {
    static constexpr bool PERM = true, AFTER_DRAIN = false;
    bf16_t* Z; float* out; bf16_t* KC; bf16_t* VC;
    __device__ __forceinline__ void operator()(const pg8::f32x4 (&acc)[2][2][4][2], const pg8::Unit& u, int wr, int wc, int fr_, int fq_) const {
        int l_ = (fq_ << 4) | fr_; asm volatile("" : "+v"(l_)); const int fr = l_ & 15, fq = l_ >> 4;
        const int row0 = u.pm * 256 + wr * 64 + fr, col0 = u.pn * 256 + wc * 32 + 8 * fq;
        const int b = u.pm >> 4, pt = u.pm & 15;
        float* fo = nullptr;
        if (pt >= 8) { if (u.pn >= 4 && u.pn < 8) fo = out + O_KP + (col0 - C_K); else if (u.pn >= 8 && u.pn < 12) fo = out + O_VP + (col0 - C_V); }
        const bool pool = (pt == 15) && (u.pn >= 16) && (u.pn < 20);
        bf16_t* cz = nullptr; int ck0 = 0;
        if (u.pn >= 4 && u.pn < 8) { cz = KC; ck0 = col0 - C_K; } else if (u.pn >= 8 && u.pn < 12) { cz = VC; ck0 = col0 - C_V; }
#pragma unroll
        for (int ai = 0; ai < 2; ++ai)
#pragma unroll
            for (int m = 0; m < 4; ++m) {
                const int row = row0 + ai * 128 + m * 16; const int pos = row & (SEQ - 1);
                bf16_t* rowp = Z + (size_t)row * INW + col0;
#pragma unroll
                for (int bj = 0; bj < 2; ++bj) {
                    const pg8::f32x4 v0 = acc[ai][bj][m][0], v1 = acc[ai][bj][m][1];
                    u32x4 w; w.x = pk2(v0[0], v0[1]); w.y = pk2(v0[2], v0[3]); w.z = pk2(v1[0], v1[1]); w.w = pk2(v1[2], v1[3]);
                    if (cz) { const int ck = ck0 + bj * 128; *(u32x4*)(cz + (((size_t)(b * NH + (ck >> 6)) * SEQ + pos) * HD + (ck & 63))) = w; }
                    else *(u32x4*)(rowp + bj * 128) = w;
                    if (fo) { float* p = fo + (size_t)(b * BUF + pos - BUF) * AW + bj * 128; *(pg8::f32x4*)p = v0; *(pg8::f32x4*)(p + 4) = v1; }
                    if (pool && pos >= SEQ - PH) { float* p = out + O_PP + (size_t)(b * PH + pos - (SEQ - PH)) * PW + (col0 - C_U) + bj * 128; *(pg8::f32x4*)p = v0; *(pg8::f32x4*)(p + 4) = v1; }
                }
            }
    }
};

#define NORM_SPIN_CAP (1u << 22)
struct EpiYN {
    static constexpr bool PERM = false, AFTER_DRAIN = true;
    const float* x; float* y; const float* gfin; float* slots; unsigned* cnt;
    __device__ __forceinline__ void fused(pg8::f32x4 (&acc)[2][2][4][2], const pg8::Unit& u, int wr, int wc, int fr, int fq, LAS unsigned char* lds, int wid, int lane) const {
        LAS float* P = (LAS float*)lds;
        LAS float* S = (LAS float*)(lds + 4096);
        const int row0 = u.pm * 256 + wr * 64 + fr, col0 = u.pn * 256 + wc * 32 + 4 * fq;
#pragma unroll
        for (int ai = 0; ai < 2; ++ai)
#pragma unroll
            for (int m = 0; m < 4; ++m) {
                const int row = row0 + ai * 128 + m * 16; float ss = 0.f;
#pragma unroll
                for (int bj = 0; bj < 2; ++bj)
#pragma unroll
                    for (int n = 0; n < 2; ++n) {
                        const f32x4 xv = __builtin_nontemporal_load((const f32x4*)(x + (size_t)row * DM + col0 + bj * 128 + n * 16));
                        pg8::f32x4 hv = acc[ai][bj][m][n]; hv[0] += xv.x; hv[1] += xv.y; hv[2] += xv.z; hv[3] += xv.w; acc[ai][bj][m][n] = hv;
                        ss += (hv[0] * hv[0] + hv[1] * hv[1]) + (hv[2] * hv[2] + hv[3] * hv[3]);
                    }
                ss += __shfl_xor(ss, 16); ss += __shfl_xor(ss, 32);
                if (fq == 0) P[(ai * 128 + wr * 64 + m * 16 + fr) * 4 + wc] = ss;
                if (m & 1) asm volatile("" ::: "memory");
            }
        asm volatile("s_waitcnt lgkmcnt(0)" ::: "memory"); __builtin_amdgcn_s_barrier(); asm volatile("" ::: "memory");
        const int t = wid * 64 + lane;
        if (t < 256) { const float s = (P[t * 4] + P[t * 4 + 1]) + (P[t * 4 + 2] + P[t * 4 + 3]);
            __hip_atomic_store(slots + (size_t)(u.pm * 256 + t) * 8 + u.pn, s, __ATOMIC_RELAXED, __HIP_MEMORY_SCOPE_AGENT); }
        asm volatile("s_waitcnt vmcnt(0)" ::: "memory");
        if (t < 256 && lane == 0) __hip_atomic_fetch_add(cnt + 64 * u.pm, 1u, __ATOMIC_RELAXED, __HIP_MEMORY_SCOPE_AGENT);
        if (wid == 0) { unsigned sp = 0;
            while ((unsigned)__builtin_amdgcn_readfirstlane(__hip_atomic_load(cnt + 64 * u.pm, __ATOMIC_RELAXED, __HIP_MEMORY_SCOPE_AGENT)) < 32u) { __builtin_amdgcn_s_sleep(2); if (++sp > NORM_SPIN_CAP) break; }
            __builtin_amdgcn_fence(__ATOMIC_ACQUIRE, "agent"); }
        asm volatile("s_waitcnt vmcnt(0) lgkmcnt(0)" ::: "memory"); __builtin_amdgcn_s_barrier(); asm volatile("" ::: "memory");
        if (t < 256) { const float* sl = slots + (size_t)(u.pm * 256 + t) * 8; float tot = 0.f;
#pragma unroll
            for (int k = 0; k < 8; ++k) tot += __hip_atomic_load(sl + k, __ATOMIC_RELAXED, __HIP_MEMORY_SCOPE_AGENT);
            S[t] = 1.f / sqrtf(tot * (1.f / DM) + EPS); }
        asm volatile("s_waitcnt vmcnt(0) lgkmcnt(0)" ::: "memory"); __builtin_amdgcn_s_barrier(); asm volatile("" ::: "memory");
        f32x4 gg[2][2];
#pragma unroll
        for (int bj = 0; bj < 2; ++bj)
#pragma unroll
            for (int n = 0; n < 2; ++n) gg[bj][n] = *(const f32x4*)(gfin + col0 + bj * 128 + n * 16);
#pragma unroll
        for (int ai = 0; ai < 2; ++ai)
#pragma unroll
            for (int m = 0; m < 4; ++m) {
                const int rl = ai * 128 + wr * 64 + m * 16 + fr; const float rs = S[rl]; const int row = u.pm * 256 + rl;
#pragma unroll
                for (int bj = 0; bj < 2; ++bj)
#pragma unroll
                    for (int n = 0; n < 2; ++n) { const pg8::f32x4 hv = acc[ai][bj][m][n]; f32x4 o; o.x = hv[0] * rs * gg[bj][n].x; o.y = hv[1] * rs * gg[bj][n].y; o.z = hv[2] * rs * gg[bj][n].z; o.w = hv[3] * rs * gg[bj][n].w;
                        *(f32x4*)(y + (size_t)row * DM + col0 + bj * 128 + n * 16) = o; }
            }
    }
};

template <class Epi>
__device__ __forceinline__ void small_gemm(LAS unsigned char* lds, const bf16_t* A, const bf16_t* Bt, int ntiles, int K, int tile0, int tstride, const Epi& E, const int tid) {
    const int  wid = tid >> 6, lane = tid & 63, fr = lane & 15, fq = lane >> 4;
    LAS float* red = (LAS float*)lds;
    const int kw = K >> 3, k0 = wid * kw;
    for (int tile = tile0; tile < ntiles; tile += tstride) {
        const int n0 = tile * 32;
        f32x4 acc[2][2];
#pragma unroll
        for (int a = 0; a < 2; ++a)
#pragma unroll
            for (int b = 0; b < 2; ++b) acc[a][b] = (f32x4){0.f, 0.f, 0.f, 0.f};
        const bf16_t* ap = A + (size_t)fr * K + k0 + fq * 8;
        const bf16_t* bp = Bt + (size_t)(n0 + fr) * K + k0 + fq * 8;
#pragma unroll 4
        for (int kk = 0; kk < kw; kk += 32) {
            const bf16x8 a0 = *(const bf16x8*)(ap + kk), a1 = *(const bf16x8*)(ap + (size_t)16 * K + kk);
            const bf16x8 b0 = *(const bf16x8*)(bp + kk), b1 = *(const bf16x8*)(bp + (size_t)16 * K + kk);
            acc[0][0] = __builtin_amdgcn_mfma_f32_16x16x32_bf16(a0, b0, acc[0][0], 0, 0, 0);
            acc[0][1] = __builtin_amdgcn_mfma_f32_16x16x32_bf16(a0, b1, acc[0][1], 0, 0, 0);
            acc[1][0] = __builtin_amdgcn_mfma_f32_16x16x32_bf16(a1, b0, acc[1][0], 0, 0, 0);
            acc[1][1] = __builtin_amdgcn_mfma_f32_16x16x32_bf16(a1, b1, acc[1][1], 0, 0, 0);
        }
#pragma unroll
        for (int mi = 0; mi < 2; ++mi)
#pragma unroll
            for (int ni = 0; ni < 2; ++ni)
#pragma unroll
                for (int j = 0; j < 4; ++j) red[wid * 1024 + (mi * 16 + fq * 4 + j) * 32 + ni * 16 + fr] = acc[mi][ni][j];
        __syncthreads();
#pragma unroll
        for (int k = 0; k < 2; ++k) { const int e = tid + 512 * k; float s = 0.f;
#pragma unroll
            for (int w = 0; w < 8; ++w) s += red[w * 1024 + e];
            E(e >> 5, n0 + (e & 31), s); }
        __syncthreads();
    }
}
struct SEpiZ {
    bf16_t* Z; float* out;
    __device__ __forceinline__ void operator()(int row, int col, float v) const {
        Z[(size_t)(MP + row) * INW + col] = (bf16_t)f2bf(v);
        const int b = row >> 2, t = row & 3;
        if (col >= C_K && col < C_V) out[O_KS + (size_t)(b * BUF + BUF - DT + t) * AW + (col - C_K)] = v;
        else if (col >= C_V && col < C_GA) out[O_VS + (size_t)(b * BUF + BUF - DT + t) * AW + (col - C_V)] = v;
        else if (col >= C_U && col < C_GP) out[O_PS + (size_t)(b * PH + PH - DT + t) * PW + (col - C_U)] = v;
    }
};
__device__ __forceinline__ void sample_out_unit(LAS unsigned char* lds, const bf16_t* A, const bf16_t* Bt, const float* xs, float* ys, const float* gfin, float* slots, unsigned* cnt, int tile, int tid) {
    const int wid = tid >> 6, lane = tid & 63, fr = lane & 15, fq = lane >> 4;
    LAS float* red = (LAS float*)lds;
    LAS float* S = (LAS float*)(lds + 32768);
    constexpr int K = DM; const int kw = K >> 3, k0 = wid * kw, n0 = tile * 32;
    f32x4 acc[2][2];
#pragma unroll
    for (int a = 0; a < 2; ++a)
#pragma unroll
        for (int b = 0; b < 2; ++b) acc[a][b] = (f32x4){0.f, 0.f, 0.f, 0.f};
    const bf16_t* ap = A + (size_t)fr * K + k0 + fq * 8;
    const bf16_t* bp = Bt + (size_t)(n0 + fr) * K + k0 + fq * 8;
#pragma unroll 4
    for (int kk = 0; kk < kw; kk += 32) {
        const bf16x8 a0 = *(const bf16x8*)(ap + kk), a1 = *(const bf16x8*)(ap + (size_t)16 * K + kk);
        const bf16x8 b0 = *(const bf16x8*)(bp + kk), b1 = *(const bf16x8*)(bp + (size_t)16 * K + kk);
        acc[0][0] = __builtin_amdgcn_mfma_f32_16x16x32_bf16(a0, b0, acc[0][0], 0, 0, 0);
        acc[0][1] = __builtin_amdgcn_mfma_f32_16x16x32_bf16(a0, b1, acc[0][1], 0, 0, 0);
        acc[1][0] = __builtin_amdgcn_mfma_f32_16x16x32_bf16(a1, b0, acc[1][0], 0, 0, 0);
        acc[1][1] = __builtin_amdgcn_mfma_f32_16x16x32_bf16(a1, b1, acc[1][1], 0, 0, 0);
    }
#pragma unroll
    for (int mi = 0; mi < 2; ++mi)
#pragma unroll
        for (int ni = 0; ni < 2; ++ni)
#pragma unroll
            for (int j = 0; j < 4; ++j) red[wid * 1024 + (mi * 16 + fq * 4 + j) * 32 + ni * 16 + fr] = acc[mi][ni][j];
    __syncthreads();
    float hv[2];
#pragma unroll
    for (int k = 0; k < 2; ++k) { const int e = tid + 512 * k, row = e >> 5, col = n0 + (e & 31); float s = 0.f;
#pragma unroll
        for (int w = 0; w < 8; ++w) s += red[w * 1024 + e];
        const float h = xs[(size_t)row * DM + col] + s; hv[k] = h;
        float ss = h * h;
#pragma unroll
        for (int o = 1; o < 32; o <<= 1) ss += __shfl_xor(ss, o);
        if ((lane & 31) == 0) __hip_atomic_store(slots + row * 64 + tile, ss, __ATOMIC_RELAXED, __HIP_MEMORY_SCOPE_AGENT); }
    asm volatile("s_waitcnt vmcnt(0)" ::: "memory");
    __syncthreads();
    if (tid == 0) { __hip_atomic_fetch_add(cnt, 1u, __ATOMIC_RELAXED, __HIP_MEMORY_SCOPE_AGENT); }
    if (wid == 0) { unsigned sp = 0;
        while ((unsigned)__builtin_amdgcn_readfirstlane(__hip_atomic_load(cnt, __ATOMIC_RELAXED, __HIP_MEMORY_SCOPE_AGENT)) < 64u) { __builtin_amdgcn_s_sleep(2); if (++sp > NORM_SPIN_CAP) break; }
        __builtin_amdgcn_fence(__ATOMIC_ACQUIRE, "agent");
        if (lane < 32) { float tot = 0.f;
#pragma unroll 8
            for (int k = 0; k < 64; ++k) tot += __hip_atomic_load(slots + lane * 64 + k, __ATOMIC_RELAXED, __HIP_MEMORY_SCOPE_AGENT);
            S[lane] = 1.f / sqrtf(tot * (1.f / DM) + EPS); } }
    __syncthreads();
#pragma unroll
    for (int k = 0; k < 2; ++k) { const int e = tid + 512 * k, row = e >> 5, col = n0 + (e & 31);
        ys[(size_t)row * DM + col] = hv[k] * S[row] * gfin[col]; }
    __syncthreads();
}

constexpr int CP_PER_B = (BUF - DT) * AW / 4, CP_N = DB * CP_PER_B, CP_ATT = 256 * 8 * 6 * 512  ;
__device__ __forceinline__ void cp_addr(const Args& a, int i, const f32x4*& src, f32x4*& dst) {
    const bool isv = i >= CP_N; const int ii = isv ? i - CP_N : i; const int b = ii / CP_PER_B, o = ii - b * CP_PER_B;
    const size_t d = (size_t)b * (BUF * AW / 4) + o;
    src = (const f32x4*)(isv ? a.cache_v : a.cache_k) + d + DT * AW / 4;
    dst = (f32x4*)(a.out + (isv ? O_VS : O_KS)) + d;
}

typedef short s16x4 __attribute__((ext_vector_type(4)));
__device__ __forceinline__ s16x4 vtr(const LAS unsigned char* p) { return __builtin_bit_cast(s16x4, __builtin_amdgcn_ds_read_tr16_b64_v4i16((LAS s16x4*)p)); }
__device__ __forceinline__ int crow(int r, int hi) { return (r & 3) + 8 * (r >> 2) + 4 * hi; }
constexpr int OSH_STRIDE = 144, OSH_BYTES = 512 * OSH_STRIDE  , LSH_OFF = OSH_BYTES, VSH_OFF = LSH_OFF + 2048, VSH_WAVE = 32 * 144  ;
constexpr int KSH2_OFF = VSH_OFF + 8 * VSH_WAVE  ;
static_assert(KSH2_OFF + 8 * VSH_WAVE <= LDS_BYTES - 64, "attention LDS map");

__device__ __forceinline__ void attn_prompt_unit(LAS unsigned char* lds, const bf16_t* Z, bf16_t* MIX, int b, int h, int blk, const int wid  , const Args& a, const int unit, const bf16_t* KC, const bf16_t* VC) {
    LAS unsigned char* Osh = lds;
    LAS float* Lsh = (LAS float*)(lds + LSH_OFF);
    LAS unsigned char* Vsh = lds + VSH_OFF + wid * VSH_WAVE;
    const int t0 = blk * 512; const size_t rowbase = (size_t)b * SEQ;
    const char* Kb = (const char*)KC + (size_t)(b * NH + h) * SEQ * (HD * 2); const char* Vb = (const char*)VC + (size_t)(b * NH + h) * SEQ * (HD * 2);
    const float SC = 0.125f * LOG2E;
#pragma unroll 1
    for (int p = 0; p < 3; ++p) {
        const int dil = 1 << (2 * p);
#pragma unroll 1
        for (int gi = 0; gi < 2; ++gi) {
            const int g = wid * 2 + gi;
            const int lane = otid(0); const int r = lane & 31, hh = lane >> 5;
            const int cpbase = (((unit * 8 + wid) * 6) + (p * 2 + gi)) * 512; f32x4 cpv[4]; unsigned cpo[4];
            const bool cp_isv = cpbase >= CP_N; const int cp_ii0 = cp_isv ? cpbase - CP_N : cpbase, cp_vb0 = cp_ii0 / CP_PER_B, cp_next = (cp_vb0 + 1) * CP_PER_B;
            const char* cp_src = (const char*)(cp_isv ? a.cache_v : a.cache_k) + (size_t)DT * AW * 4; char* cp_dst = (char*)(a.out + (cp_isv ? O_VS : O_KS));
#define CP_OFF(K_) ({ const int ii_ = cp_ii0 + (K_) + lane; (unsigned)(ii_ + (ii_ >= cp_next ? cp_vb0 + 1 : cp_vb0) * 1024) * 16u; })
            const char* Zb = (const char*)Z; constexpr unsigned ROWB = INW * 2; const unsigned rb0 = (unsigned)rowbase;
            const LAS unsigned char* vtb = Vsh + (4 * hh + ((lane & 15) >> 2)) * 144 + (16 * ((lane >> 4) & 1) + 4 * (lane & 3)) * 2;
            const int qbase = t0 + (g & (dil - 1)) + dil * 32 * (g >> (2 * p));
            const int qpos = qbase + dil * r;
            const unsigned qoff = (rb0 + (unsigned)qpos) * ROWB + (unsigned)((C_Q + h * HD + hh * 8) * 2);
            bf16x8 bq[4];
#pragma unroll
            for (int s = 0; s < 4; ++s) bq[s] = *(const bf16x8*)(Zb + (size_t)qoff + 32 * s);
            f32x16 X[5];
            {
                u32x4 kr[5][4];
                const int ka0 = qbase + dil * ((lane >> 3) - 128);
                const unsigned kcolb = (unsigned)((C_K + h * HD + (lane & 7) * 8) * 2);
#pragma unroll
                for (int T = 0; T < 5; ++T)
#pragma unroll
                    for (int c = 0; c < 4; ++c) { const int kpos = ka0 + (32 * T + 8 * c) * dil;
                        kr[T][c] = *(const u32x4*)(Kb + (size_t)((unsigned)(kpos < 0 ? 0 : kpos) * 128u + (unsigned)((lane & 7) * 16))); }
#pragma unroll
                for (int u = 0; u < 4; ++u) { cpo[u] = CP_OFF(64 * u); cpv[u] = __builtin_nontemporal_load((const f32x4*)(cp_src + (size_t)cpo[u])); }
                __builtin_amdgcn_sched_barrier(0);
                LAS unsigned char* Ksh2 = lds + KSH2_OFF + wid * VSH_WAVE;
#pragma unroll
                for (int T = 0; T < 5; ++T) {
                    LAS unsigned char* kb = (T & 1) ? Ksh2 : Vsh;
#pragma unroll
                    for (int c = 0; c < 4; ++c) *(LAS u32x4*)(kb + ((lane >> 3) + 8 * c) * 144 + (lane & 7) * 16) = kr[T][c];
                    f32x16 x;
#pragma unroll
                    for (int i = 0; i < 16; ++i) x[i] = 0.f;
#pragma unroll
                    for (int s = 0; s < 4; ++s) { const bf16x8 ka = *(const LAS bf16x8*)(kb + r * 144 + 32 * s + 16 * hh);
                        x = __builtin_amdgcn_mfma_f32_32x32x16_bf16(ka, bq[s], x, 0, 0, 0); }
                    X[T] = x;
                }
                __builtin_amdgcn_sched_barrier(0);
            }
            u32x4 vf[5][4];
            const int va0 = qbase + dil * ((lane >> 3) - 128); const unsigned vcolb = (unsigned)((C_V + h * HD + (lane & 7) * 8) * 2);
#pragma unroll
            for (int T = 0; T < 3; ++T)
#pragma unroll
                for (int c = 0; c < 4; ++c) { const int kposn = va0 + (32 * T + 8 * c) * dil;
                    vf[T][c] = *(const u32x4*)(Vb + (size_t)((unsigned)(kposn < 0 ? 0 : kposn) * 128u + (unsigned)((lane & 7) * 16))); }
#pragma unroll
            for (int u = 0; u < 4; ++u) __builtin_nontemporal_store(cpv[u], (f32x4*)(cp_dst + (size_t)cpo[u]));
#pragma unroll
            for (int u = 0; u < 4; ++u) { cpo[u] = CP_OFF(256 + 64 * u); cpv[u] = __builtin_nontemporal_load((const f32x4*)(cp_src + (size_t)cpo[u])); }
            __builtin_amdgcn_sched_barrier(0);
            const int nneg = 128 - (qbase >> (2 * p));
            const int nlo = (r > nneg ? r : nneg) - 4 * hh, nhi = r + 128 - 4 * hh;
            const int tneg = (nneg > 0) ? ((nneg - 1) >> 5) : -1;
            float mraw = -INFINITY;
#pragma unroll
            for (int T = 0; T < 5; ++T) {
                if (T == 0 || T == 4 || T <= tneg) {
#pragma unroll
                    for (int i = 0; i < 16; ++i) {
                        const int nc = 32 * T + (i & 3) + 8 * (i >> 2);
                        const bool valid = (T == 4 ? nc <= nhi : true) && (T < 4 ? nc >= nlo : true);
                        const float v = valid ? X[T][i] : -INFINITY; X[T][i] = v; mraw = fmaxf(mraw, v);
                    }
                } else {
#pragma unroll
                    for (int i = 0; i < 16; ++i) mraw = fmaxf(mraw, X[T][i]);
                }
            }
            { auto rr = __builtin_amdgcn_permlane32_swap(__float_as_uint(mraw), __float_as_uint(mraw), false, false); mraw = fmaxf(__uint_as_float(rr[0]), __uint_as_float(rr[1])); }
            const float m = mraw * SC, negm = -m;
            float l = 0.f;
#pragma unroll
            for (int T = 0; T < 5; ++T)
#pragma unroll
                for (int i = 0; i < 16; ++i) { const float pe = __builtin_amdgcn_exp2f(__builtin_fmaf(X[T][i], SC, negm)); X[T][i] = pe; l += pe; }
            { auto rr = __builtin_amdgcn_permlane32_swap(__float_as_uint(l), __float_as_uint(l), false, false); l = __uint_as_float(rr[0]) + __uint_as_float(rr[1]); }
            __builtin_amdgcn_sched_barrier(0);
            f32x16 o0, o1;
#pragma unroll
            for (int i = 0; i < 16; ++i) { o0[i] = 0.f; o1[i] = 0.f; }
#pragma unroll
            for (int T = 0; T < 5; ++T) {
                if (T == 1) {
#pragma unroll
                    for (int T2 = 3; T2 < 5; ++T2)
#pragma unroll
                        for (int c = 0; c < 4; ++c) { const int kposn = va0 + (32 * T2 + 8 * c) * dil;
                            vf[T2][c] = *(const u32x4*)(Vb + (size_t)((unsigned)(kposn < 0 ? 0 : kposn) * 128u + (unsigned)((lane & 7) * 16))); }
                }
#pragma unroll
                for (int c = 0; c < 4; ++c) { const int chunk = lane + 64 * c, vr = chunk >> 3, vc = chunk & 7;
                    *(LAS u32x4*)(Vsh + vr * 144 + vc * 16) = vf[T][c]; }
                __builtin_amdgcn_sched_barrier(0);
#pragma unroll
                for (int s2 = 0; s2 < 2; ++s2) {
                    bf16x8 pb;
#pragma unroll
                    for (int j = 0; j < 8; j += 2) { const unsigned w = pk2(X[T][8 * s2 + j], X[T][8 * s2 + j + 1]); pb[j] = (short)(w & 0xffffu); pb[j + 1] = (short)(w >> 16); }
                    const s16x4 a0lo = vtr(vtb + (16 * s2) * 144),      a0hi = vtr(vtb + (16 * s2 + 8) * 144);
                    const s16x4 a1lo = vtr(vtb + (16 * s2) * 144 + 64), a1hi = vtr(vtb + (16 * s2 + 8) * 144 + 64);
                    const bf16x8 va0 = (bf16x8){a0lo[0], a0lo[1], a0lo[2], a0lo[3], a0hi[0], a0hi[1], a0hi[2], a0hi[3]};
                    const bf16x8 va1 = (bf16x8){a1lo[0], a1lo[1], a1lo[2], a1lo[3], a1hi[0], a1hi[1], a1hi[2], a1hi[3]};
                    o0 = __builtin_amdgcn_mfma_f32_32x32x16_bf16(va0, pb, o0, 0, 0, 0);
                    o1 = __builtin_amdgcn_mfma_f32_32x32x16_bf16(va1, pb, o1, 0, 0, 0);
                }
                __builtin_amdgcn_sched_barrier(0);
            }
#pragma unroll
            for (int u = 0; u < 4; ++u) __builtin_nontemporal_store(cpv[u], (f32x4*)(cp_dst + (size_t)cpo[u]));
#undef CP_OFF
            const float inv = 1.f / l; float L2 = m + __builtin_amdgcn_logf(l);
            const int ql = qpos - t0;
            float wo = 0.f, wn = inv;
            if (p > 0) { const float Lold = Lsh[ql]; const float mx = fmaxf(Lold, L2);
                const float Ln = mx + __builtin_amdgcn_logf(__builtin_amdgcn_exp2f(Lold - mx) + __builtin_amdgcn_exp2f(L2 - mx));
                wo = __builtin_amdgcn_exp2f(Lold - Ln); wn = __builtin_amdgcn_exp2f(L2 - Ln) * inv; L2 = Ln; }
#pragma unroll
            for (int dh = 0; dh < 2; ++dh)
#pragma unroll
                for (int g4 = 0; g4 < 4; ++g4) {
                    LAS u32x2* op = (LAS u32x2*)(Osh + ql * OSH_STRIDE + (32 * dh + 8 * g4 + 4 * hh) * 2);
                    float v0, v1, v2, v3;
                    if (dh == 0) { v0 = o0[4 * g4] * wn; v1 = o0[4 * g4 + 1] * wn; v2 = o0[4 * g4 + 2] * wn; v3 = o0[4 * g4 + 3] * wn; }
                    else         { v0 = o1[4 * g4] * wn; v1 = o1[4 * g4 + 1] * wn; v2 = o1[4 * g4 + 2] * wn; v3 = o1[4 * g4 + 3] * wn; }
                    if (p > 0) { const u32x2 old = *op; v0 += bflo(old.x) * wo; v1 += bfhi(old.x) * wo; v2 += bflo(old.y) * wo; v3 += bfhi(old.y) * wo; }
                    u32x2 nw; nw.x = pk2(v0, v1); nw.y = pk2(v2, v3); *op = nw;
                }
            if (hh == 0) Lsh[ql] = L2;
        }
        __syncthreads();
    }
    const int tid = otid(wid);
#pragma unroll
    for (int it = 0; it < 8; ++it) { const int chunk = tid + 512 * it, row = chunk >> 3, c = chunk & 7;
        const u32x4 ov = *(const LAS u32x4*)(Osh + row * OSH_STRIDE + c * 16);
        const size_t grow = rowbase + t0 + row;
        const u32x4 gv = __builtin_nontemporal_load((const u32x4*)(Z + grow * INW + C_GA + h * HD + c * 8));
        u32x4 w;
        w.x = pk2(bflo(ov.x) * silu(bflo(gv.x)), bfhi(ov.x) * silu(bfhi(gv.x)));
        w.y = pk2(bflo(ov.y) * silu(bflo(gv.y)), bfhi(ov.y) * silu(bfhi(gv.y)));
        w.z = pk2(bflo(ov.z) * silu(bflo(gv.z)), bfhi(ov.z) * silu(bfhi(gv.z)));
        w.w = pk2(bflo(ov.w) * silu(bflo(gv.w)), bfhi(ov.w) * silu(bfhi(gv.w)));
        *(u32x4*)(MIX + grow * DM + h * HD + c * 8) = w; }
    __syncthreads();
}

template <int W>
__device__ __forceinline__ void pooled_item(const bf16_t* up, bf16_t* pp, int row0, int pos0) {
    u32x4 R[W + 7];
#pragma unroll
    for (int k = 0; k < W + 7; ++k) { const int d = k - (W - 1);
        R[k] = (pos0 + d >= 0) ? *(const u32x4*)(up + (size_t)(row0 + d) * INW) : (u32x4){0u, 0u, 0u, 0u}; }
    float S[8];
#pragma unroll
    for (int c = 0; c < 8; ++c) S[c] = 0.f;
#pragma unroll
    for (int k = 0; k < W - 1; ++k) { S[0] += bflo(R[k].x); S[1] += bfhi(R[k].x); S[2] += bflo(R[k].y); S[3] += bfhi(R[k].y); S[4] += bflo(R[k].z); S[5] += bfhi(R[k].z); S[6] += bflo(R[k].w); S[7] += bfhi(R[k].w); }
#pragma unroll
    for (int j = 0; j < 8; ++j) {
        const u32x4 v = R[W - 1 + j], q = R[j];
        const float c[8] = {bflo(v.x), bfhi(v.x), bflo(v.y), bfhi(v.y), bflo(v.z), bfhi(v.z), bflo(v.w), bfhi(v.w)};
        const int pos = pos0 + j; const float icnt = 1.f / (float)((pos + 1 < W) ? pos + 1 : W);
        float o[8];
#pragma unroll
        for (int k = 0; k < 8; ++k) { S[k] += c[k]; o[k] = S[k] * icnt - c[k]; }
        u32x4 ov; ov.x = pk2(o[0], o[1]); ov.y = pk2(o[2], o[3]); ov.z = pk2(o[4], o[5]); ov.w = pk2(o[6], o[7]);
        *(u32x4*)(pp + (size_t)(row0 + j) * 256) = ov;
        S[0] -= bflo(q.x); S[1] -= bfhi(q.x); S[2] -= bflo(q.y); S[3] -= bfhi(q.y); S[4] -= bflo(q.z); S[5] -= bfhi(q.z); S[6] -= bflo(q.w); S[7] -= bfhi(q.w);
    }
}

template <int CH>
__device__ __forceinline__ void pool_tile16(LAS unsigned char* lds, const bf16x8 (&tf)[8]  , const bf16_t* zrow  , bf16_t* orow  ,
                                            const float* pool_scale, int g, int fr, int fq, int nt0, int nchunks) {
    u32x2 gvv[CH], gvn[CH]; f32x4 scv[CH], scn[CH];
#pragma unroll
    for (int k = 0; k < CH; ++k) { const int c = g * 256 + (nt0 + k) * 16 + 4 * fq; gvv[k] = *(const u32x2*)(zrow + C_GP + c); scv[k] = *(const f32x4*)(pool_scale + c); }
#pragma unroll 1
    for (int ch = 0; ch < nchunks; ++ch) {
        const int chn = (ch + 1 < nchunks) ? ch + 1 : ch;
#pragma unroll
        for (int k = 0; k < CH; ++k) { const int c = g * 256 + (nt0 + CH * chn + k) * 16 + 4 * fq; gvn[k] = *(const u32x2*)(zrow + C_GP + c); scn[k] = *(const f32x4*)(pool_scale + c); }
#pragma unroll
        for (int k = 0; k < CH; ++k) {
            const int nt = nt0 + CH * ch + k;
            f32x4 acc = (f32x4){0.f, 0.f, 0.f, 0.f};
#pragma unroll
            for (int s = 0; s < 8; ++s) { const bf16x8 wf = *(const LAS bf16x8*)(lds + (nt * 16 + fr) * 528 + (32 * s + 8 * fq) * 2);
                acc = __builtin_amdgcn_mfma_f32_16x16x32_bf16(wf, tf[s], acc, 0, 0, 0); }
            const int c = g * 256 + nt * 16 + 4 * fq;
            const f32x4 sc = scv[k]; const u32x2 gv = gvv[k];
            u32x2 w; w.x = pk2(acc[0] * sc.x * silu(bflo(gv.x)), acc[1] * sc.y * silu(bfhi(gv.x))); w.y = pk2(acc[2] * sc.z * silu(bflo(gv.y)), acc[3] * sc.w * silu(bfhi(gv.y)));
            *(u32x2*)(orow + AW + c) = w;
        }
#pragma unroll
        for (int k = 0; k < CH; ++k) { gvv[k] = gvn[k]; scv[k] = scn[k]; }
    }
}
__device__ __forceinline__ void pool_stage(LAS unsigned char* lds, const bf16_t* WPOOL, int g, int tid) {
    const bf16_t* Wg = WPOOL + (size_t)g * 65536;
    u32x4 wv[16];
#pragma unroll
    for (int k = 0; k < 16; ++k) { const int i = tid + 512 * k; wv[k] = *(const u32x4*)(Wg + (i >> 5) * 256 + (i & 31) * 8); }
#pragma unroll
    for (int k = 0; k < 16; ++k) { const int i = tid + 512 * k; *(LAS u32x4*)(lds + (i >> 5) * 528 + (i & 31) * 16) = wv[k]; }
}
__device__ __forceinline__ void pool_unit(LAS unsigned char* lds, const bf16_t* POOLED, const bf16_t* POOLEDS, const bf16_t* WPOOL, const bf16_t* Z, bf16_t* MIX, const float* pool_scale, int g, int rb, int tid, bool staged) {
    const int lane = tid & 63, wave = tid >> 6, fr = lane & 15, fq = lane >> 4;
    const int row = rb * 128 + wave * 16 + fr;
    bf16x8 tf[8];
    { const bf16_t* arow = POOLED + ((size_t)g * MP + row) * 256 + fq * 8;
#pragma unroll
      for (int s = 0; s < 8; ++s) tf[s] = __builtin_nontemporal_load((const bf16x8*)(arow + 32 * s)); }
    if (!staged) pool_stage(lds, WPOOL, g, tid);
    __syncthreads();
    pool_tile16<4>(lds, tf, Z + (size_t)row * INW, MIX + (size_t)row * DM, pool_scale, g, fr, fq, 0, 4);
    if (rb == 0) {
#pragma unroll 1
        for (int hf = 0; hf < 2; ++hf) { const int srow = hf * 16 + fr; bf16x8 ts[8];
            { const bf16_t* arow = POOLEDS + ((size_t)g * MS + srow) * 256 + fq * 8;
#pragma unroll
              for (int s = 0; s < 8; ++s) ts[s] = __builtin_nontemporal_load((const bf16x8*)(arow + 32 * s)); }
            pool_tile16<2>(lds, ts, Z + (size_t)(MP + srow) * INW, MIX + (size_t)(MP + srow) * DM, pool_scale, g, fr, fq, 2 * wave, 1); }
    }
    __syncthreads();
}

__device__ __forceinline__ void attn_sample_round(LAS unsigned char* lds, const Args& a, const bf16_t* Z, bf16_t* MIX, int task, int tid) {
    const int lane = tid & 63, wave = tid >> 6, q4 = wave & 3, half = wave >> 2;
    LAS float* msh = (LAS float*)(lds + 8192);
    const bool act = task < DB * DT * NH;
    const int h = task & 15, t = (task >> 4) & 3, b = (task >> 6) & 7;
    const size_t zrow = (size_t)(MP + b * DT + t) * INW;
    if (act) {
        const float* ks = a.out + O_KS; const float* vs = a.out + O_VS;
        const int slot = lane >> 4, c4 = lane & 15, e0 = 97 * q4;
        float qv[4];
        { const u32x2 w = *(const u32x2*)(Z + zrow + C_Q + h * HD + 4 * c4); qv[0] = bflo(w.x); qv[1] = bfhi(w.x); qv[2] = bflo(w.y); qv[3] = bfhi(w.y); }
        float sc[25]; float m = -INFINITY;
#pragma unroll
        for (int i = 0; i < 25; ++i) {
            const int el = slot + 4 * i, e = e0 + el; const bool valid = (el < 97) && (e < 387); const int ec = valid ? e : 0;
            const int p = (ec >= 129) + (ec >= 258), j = ec - 129 * p, R = BUF + t - (j << (2 * p));
            const float* kr = (R < BUF) ? a.cache_k + ((size_t)(b * BUF + R) * NH + h) * HD : ks + ((size_t)(b * BUF + R - DT) * NH + h) * HD;
            const f32x4 kv = __builtin_nontemporal_load((const f32x4*)(kr + 4 * c4));
            float s = (qv[0] * kv.x + qv[1] * kv.y) + (qv[2] * kv.z + qv[3] * kv.w);
            s += __shfl_xor(s, 1); s += __shfl_xor(s, 2); s += __shfl_xor(s, 4); s += __shfl_xor(s, 8);
            s = valid ? s * 0.125f * LOG2E : -INFINITY; sc[i] = s; m = fmaxf(m, s);
        }
        m = fmaxf(m, __shfl_xor(m, 16)); m = fmaxf(m, __shfl_xor(m, 32));
        float l = 0.f;
#pragma unroll
        for (int i = 0; i < 25; ++i) { const float pe = __builtin_amdgcn_exp2f(sc[i] - m); sc[i] = pe; l += pe; }
        l += __shfl_xor(l, 16); l += __shfl_xor(l, 32);
        f32x4 acc = (f32x4){0.f, 0.f, 0.f, 0.f};
#pragma unroll
        for (int i = 0; i < 25; ++i) {
            const int el = slot + 4 * i, e = e0 + el; const bool valid = (el < 97) && (e < 387); const int ec = valid ? e : 0;
            const float pe = sc[i];
            const int p = (ec >= 129) + (ec >= 258), j = ec - 129 * p, R = BUF + t - (j << (2 * p));
            const float* vr = (R < BUF) ? a.cache_v + ((size_t)(b * BUF + R) * NH + h) * HD : vs + ((size_t)(b * BUF + R - DT) * NH + h) * HD;
            const f32x4 vv = __builtin_nontemporal_load((const f32x4*)(vr + 4 * c4));
            acc.x += pe * vv.x; acc.y += pe * vv.y; acc.z += pe * vv.z; acc.w += pe * vv.w;
        }
        acc.x += __shfl_xor(acc.x, 16); acc.y += __shfl_xor(acc.y, 16); acc.z += __shfl_xor(acc.z, 16); acc.w += __shfl_xor(acc.w, 16);
        acc.x += __shfl_xor(acc.x, 32); acc.y += __shfl_xor(acc.y, 32); acc.z += __shfl_xor(acc.z, 32); acc.w += __shfl_xor(acc.w, 32);
        if (lane < 16) { LAS float* d = msh + wave * 68 + 4 * c4; d[0] = acc.x; d[1] = acc.y; d[2] = acc.z; d[3] = acc.w; }
        if (lane == 0) { msh[wave * 68 + 64] = m; msh[wave * 68 + 65] = l; }
    }
    __syncthreads();
    if (act && q4 == 0 && lane < 16) {
        const LAS float* s0 = msh + (half * 4) * 68;
        const float m0 = s0[64], m1 = s0[68 + 64], m2 = s0[136 + 64], m3 = s0[204 + 64];
        const float M = fmaxf(fmaxf(m0, m1), fmaxf(m2, m3));
        const float w0 = __builtin_amdgcn_exp2f(m0 - M), w1 = __builtin_amdgcn_exp2f(m1 - M), w2 = __builtin_amdgcn_exp2f(m2 - M), w3 = __builtin_amdgcn_exp2f(m3 - M);
        const float L = s0[65] * w0 + s0[68 + 65] * w1 + s0[136 + 65] * w2 + s0[204 + 65] * w3;
        const float inv = 1.f / L;
        float o[4];
#pragma unroll
        for (int k = 0; k < 4; ++k) o[k] = (s0[4 * lane + k] * w0 + s0[68 + 4 * lane + k] * w1 + s0[136 + 4 * lane + k] * w2 + s0[204 + 4 * lane + k] * w3) * inv;
        const u32x2 gv = *(const u32x2*)(Z + zrow + C_GA + h * HD + 4 * lane);
        u32x2 w; w.x = pk2(o[0] * silu(bflo(gv.x)), o[1] * silu(bfhi(gv.x))); w.y = pk2(o[2] * silu(bflo(gv.y)), o[3] * silu(bfhi(gv.y)));
        *(u32x2*)(MIX + (size_t)(MP + b * DT + t) * DM + h * HD + 4 * lane) = w;
    }
    __syncthreads();
}

__global__ void __launch_bounds__(512, 2) hymba_fwd(Args a) {
    extern __shared__ __attribute__((aligned(16))) unsigned char lds_raw[];
    LAS unsigned char* lds = (LAS unsigned char*)lds_raw;
    cg::grid_group grid = cg::this_grid();
    if (a.ws == nullptr) grid.sync();
    if (threadIdx.x < 4) ((volatile LAS unsigned*)(lds + LDS_BYTES - 64))[threadIdx.x] = 0u;
    __syncthreads();
    const XcdBarrier xbar = xcd_barrier_post((unsigned*)(a.ws + WS_BAR), (volatile LAS unsigned*)(lds + LDS_BYTES - 64));
    const int G = gridDim.x, bx = blockIdx.x;
    const int wave0 = __builtin_amdgcn_readfirstlane(threadIdx.x >> 6);
    const int vcu = osgpr((G % 8 == 0) ? (bx % 8) * (G / 8) + bx / 8 : bx);
#define PHASE_IDS const int tid = otid(wave0), lane = tid & 63, wave = wave0; \
    const int gw = osgpr(vcu * 8 + wave), NGW = G * 8, gt = osgpr(vcu * 512) + tid, NGT = G * 512; (void)gw; (void)NGW; (void)gt; (void)NGT; (void)lane;
    unsigned char* ws = a.ws;
    bf16_t* WIN = (bf16_t*)(ws + WS_WIN); bf16_t* WOUT = (bf16_t*)(ws + WS_WOUT); bf16_t* WPOOL = (bf16_t*)(ws + WS_WPOOL);
    bf16_t* XN = (bf16_t*)(ws + WS_XN); bf16_t* Z = (bf16_t*)(ws + WS_Z); bf16_t* MIX = (bf16_t*)(ws + WS_MIX);
    bf16_t* POOLED = (bf16_t*)(ws + WS_POOLED); bf16_t* POOLEDS = (bf16_t*)(ws + WS_POOLEDS);

#if PHM & 1
    for (int rep_ = 0; rep_ < 1 + ((PHDUP >> 0) & 1); ++rep_) {
        PHASE_IDS
        LAS float* scr = (LAS float*)(lds + wave * 16384);
        constexpr int I_IN = (DM / 64) * (INW / 32), I_OUT = (DM / 64) * (DM / 32), I_PL = (256 / 64) * (256 / 32);
        constexpr int NITEMS = I_IN + 4 * I_PL;
        for (int it = gw; it < NITEMS; it += NGW) {
            int r = it;
            if (r < I_IN) { p0_transpose_item(a.w_in, DM, INW, WIN, scr, r, lane); continue; } r -= I_IN;
            const int g = r / I_PL; r -= g * I_PL;
            p0_transpose_item(a.w_pool + (size_t)g * 65536, 256, 256, WPOOL + (size_t)g * 65536, scr, r, lane);
        }
        for (int m = gw; m < MT; m += NGW) {
            const float* xr = (m < MP) ? a.x_prompt + (size_t)m * DM : a.x_sample + (size_t)(m - MP) * DM;
            rms_row_to_bf16(xr, a.norm_g, XN + (size_t)m * DM, lane);
        }
        {
            for (int i0 = CP_ATT + gt; i0 < 2 * CP_N; i0 += 8 * NGT) {
                f32x4 cv[8]; f32x4* cd[8];
#pragma unroll
                for (int u = 0; u < 8; ++u) { const int i = i0 + u * NGT; const f32x4* sp; cp_addr(a, i < 2 * CP_N ? i : CP_ATT, sp, cd[u]); cv[u] = __builtin_nontemporal_load(sp); }
#pragma unroll
                for (int u = 0; u < 8; ++u) if (i0 + u * NGT < 2 * CP_N) __builtin_nontemporal_store(cv[u], cd[u]);
            }
            constexpr int PPER_B = (PH - DT) * PW / 4, NPP = DB * PPER_B;
            f32x4* pd = (f32x4*)(a.out + O_PS); const f32x4* psrc = (const f32x4*)a.state_pool;
            for (int i = gt; i < NPP; i += NGT) { const int b = i / PPER_B, o = i - b * PPER_B;
                pd[(size_t)b * (PH * PW / 4) + o] = psrc[(size_t)b * (PH * PW / 4) + DT * PW / 4 + o]; }
        }
    }
#endif
    GRID_SYNC();

#if PHM & 2
    for (int rep_ = 0; rep_ < 1 + ((PHDUP >> 1) & 1); ++rep_) {
        SEpiZ se{Z, a.out};
        small_gemm(lds, XN + (size_t)MP * DM, WIN, INW / 32, DM, bx, G, se, otid(wave0));
        pg8::Gemm g{XN, WIN, MP, INW, DM}; pg8::StaticOrder S; S.init(MP, INW, G, bx);
        EpiZ E{Z, a.out, (bf16_t*)(ws + WS_KC), (bf16_t*)(ws + WS_VC)};
        pg8::gemm_phase<EpiZ, pg8::StaticOrder, true, true>(lds, g, S, E, otid(wave0));
    }
#endif
    GRID_SYNC();

#if PHM & 4
    for (int rep_ = 0; rep_ < 1 + ((PHDUP >> 2) & 1); ++rep_) {
        PHASE_IDS
        for (int u = vcu; u < NB * NH * 8; u += G) attn_prompt_unit(lds, Z, MIX, u >> 7, (u >> 3) & 15, u & 7, wave0, a, u, (const bf16_t*)(ws + WS_KC), (const bf16_t*)(ws + WS_VC));
        {
            LAS float* scr = (LAS float*)(lds + wave * 16384);
            constexpr int I_OUT2 = (DM / 64) * (DM / 32);
            for (int it = gw; it < I_OUT2; it += NGW) p0_transpose_item(a.w_out, DM, DM, WOUT, scr, it, lane);
            __syncthreads();
        }
        for (int item = gt; item < 4 * (MP / 8) * 32; item += NGT) {
            const int cc = item & 31, rc = (item >> 5) & (MP / 8 - 1), g = item >> 15, row0 = rc * 8, pos0 = row0 & (SEQ - 1);
            const bf16_t* up = Z + C_U + g * 256 + cc * 8; bf16_t* pp = POOLED + ((size_t)g * MP) * 256 + cc * 8;
            if (g == 0) pooled_item<2>(up, pp, row0, pos0); else if (g == 1) pooled_item<4>(up, pp, row0, pos0);
            else if (g == 2) pooled_item<8>(up, pp, row0, pos0); else pooled_item<16>(up, pp, row0, pos0);
        }
        for (int i = gt; i < MS * PW; i += NGT) {
            const int c = i & (PW - 1), rw = i >> 10, b = rw >> 2, t = rw & 3, g = c >> 8, w = 2 << g;
            float s = 0.f, cur = 0.f;
#pragma unroll
            for (int k = 0; k < 16; ++k) if (k < w) { const int e = PH + t - k;
                const float v = (e < PH) ? a.state_pool[((size_t)b * PH + e) * PW + c] : __builtin_bit_cast(float, (unsigned)Z[(size_t)(MP + b * DT + e - PH) * INW + C_U + c] << 16);
                s += v; if (k == 0) cur = v; }
            POOLEDS[((size_t)g * MS + rw) * 256 + (c & 255)] = (bf16_t)f2bf(s / (float)w - cur);
        }
        if (vcu < 256) { __syncthreads(); pool_stage(lds, WPOOL, vcu >> 6, tid); }
    }
#endif
    GRID_SYNC();

#if PHM & 8
    for (int rep_ = 0; rep_ < 1 + ((PHDUP >> 3) & 1); ++rep_) {
        PHASE_IDS
        for (int u = vcu; u < 256; u += G) pool_unit(lds, POOLED, POOLEDS, WPOOL, Z, MIX, a.pool_scale, u >> 6, u & 63, tid, (u == vcu) && (PHDUP == 0));
        for (int pi = vcu; pi < DB * DT * NH / 2; pi += G) attn_sample_round(lds, a, Z, MIX, 2 * pi + (wave >> 2), tid);
    }
#endif
    GRID_SYNC();

#if PHM & 16
    for (int rep_ = 0; rep_ < 1 + ((PHDUP >> 4) & 1); ++rep_) {
        if (bx < DM / 32) sample_out_unit(lds, MIX + (size_t)MP * DM, WOUT, a.x_sample, a.out + O_YS, a.final_g, (float*)(ws + WS_SLOTS) + (size_t)MP * 8, (unsigned*)(ws + WS_CNT) + 64 * 32, bx, otid(wave0));
        pg8::Gemm g{MIX, WOUT, MP, DM, DM}; pg8::StaticOrder S; S.init(MP, DM, G, bx);
        EpiYN E{a.x_prompt, a.out + O_YP, a.final_g, (float*)(ws + WS_SLOTS), (unsigned*)(ws + WS_CNT)};
        pg8::gemm_phase<EpiYN, pg8::StaticOrder, false, true>(lds, g, S, E, otid(wave0));
    }
#endif
}

extern "C" void kernel_launch(void* const* d_in, const int* in_sizes, int n_in, void* d_out, int out_size, void* d_ws, size_t ws_size, hipStream_t stream) {
    static int grid = 0;
    if (grid == 0) {
        int dev = 0, cus = 0, per_cu = 0;
        hipGetDevice(&dev);
        hipDeviceGetAttribute(&cus, hipDeviceAttributeMultiprocessorCount, dev);
        if (hipFuncSetAttribute((const void*)hymba_fwd, hipFuncAttributeMaxDynamicSharedMemorySize, LDS_BYTES) != hipSuccess) { fprintf(stderr, "hipFuncSetAttribute failed\n"); grid = -1; return; }
        if (hipOccupancyMaxActiveBlocksPerMultiprocessor(&per_cu, (const void*)hymba_fwd, 512, LDS_BYTES) != hipSuccess || per_cu < 1) { fprintf(stderr, "occupancy query: %d\n", per_cu); per_cu = 1; }
        (void)hipGetLastError();
        grid = cus;
    }
    if (grid < 0) return;
    if (hipMemsetAsync(d_ws, 0, CTL_ZERO_BYTES, stream) != hipSuccess) { fprintf(stderr, "memset failed\n"); return; }
    Args a{};
    a.x_prompt = (const float*)d_in[0]; a.x_sample = (const float*)d_in[1]; a.cache_k = (const float*)d_in[2]; a.cache_v = (const float*)d_in[3];
    a.state_pool = (const float*)d_in[4]; a.norm_g = (const float*)d_in[5]; a.w_in = (const float*)d_in[6]; a.w_pool = (const float*)d_in[7];
    a.pool_scale = (const float*)d_in[8]; a.w_out = (const float*)d_in[9]; a.final_g = (const float*)d_in[10];
    a.out = (float*)d_out; a.ws = (unsigned char*)d_ws;
    void* args[] = {&a};
    hipError_t e = hipLaunchCooperativeKernel((const void*)hymba_fwd, dim3(grid), dim3(512), args, LDS_BYTES, stream);
    if (e != hipSuccess) fprintf(stderr, "cooperative launch failed: %s (grid %d)\n", hipGetErrorString(e), grid);
}
```
